# Optimizing an MI355X kernel written in HIP

```python
import jax, jax.numpy as jnp
from jax import lax
import numpy as np

D_MODEL = 1024
BATCH = 1
SEQ = 16384
DEPTH = 1
DEC_BATCH = 128
DEC_SEQ = 8
PAST_LEN = 16384
PAGE_SIZE = 128

N_Q_HEADS = 8
N_KV_HEADS = 2
GROUP = N_Q_HEADS // N_KV_HEADS
HEAD_DIM = 64
ATTN_Q = N_Q_HEADS * HEAD_DIM
ATTN_KV = N_KV_HEADS * HEAD_DIM
WINDOW = 128
ROPE_THETA = 10000.0
CHUNK = 128
SG_GROUPS = 4
SG_GROUP_DIM = 128
SG_WIDTH = SG_GROUPS * SG_GROUP_DIM
N_MEM = 256
MEM_HEADS = 4
MEM_HEAD_DIM = 128
MEM_Q = MEM_HEADS * MEM_HEAD_DIM
N_BRANCHES = 3
BRANCH_WIDTH = 512
D_FF = 2816
CONV_WIDTH = 3
EPS = 1e-6
NEG_INF = -1e30
IN_SPLITS = (ATTN_Q, ATTN_KV, ATTN_KV, SG_WIDTH, SG_WIDTH, MEM_Q, N_BRANCHES * D_MODEL)
IN_WIDTH = sum(IN_SPLITS)
IN_OFFSETS = tuple(int(o) for o in np.cumsum(IN_SPLITS)[:-1])

kernel_name = 'gated_parallel_swa_sgmlp_memory_decoder_step'


def rms_norm(x, g):
    xf = x.astype(jnp.float32)
    y = xf * lax.rsqrt(jnp.mean(jnp.square(xf), axis=-1, keepdims=True) + EPS)
    return (y * g.astype(jnp.float32)).astype(x.dtype)


def layer_norm(x, g, b):
    xf = x.astype(jnp.float32)
    xc = xf - jnp.mean(xf, axis=-1, keepdims=True)
    var = jnp.mean(jnp.square(xc), axis=-1, keepdims=True)
    return (xc * lax.rsqrt(var + EPS) * g.astype(jnp.float32) + b.astype(jnp.float32)).astype(x.dtype)


def rope(x, pos):
    half = x.shape[-1] // 2
    inv_freq = ROPE_THETA ** (-jnp.arange(half, dtype=jnp.float32) / half)
    ang = pos.astype(jnp.float32)[:, None] * inv_freq[None, :]
    cos = jnp.cos(ang)[:, None, :]
    sin = jnp.sin(ang)[:, None, :]
    xf = x.astype(jnp.float32)
    x1, x2 = xf[..., :half], xf[..., half:]
    return jnp.concatenate([x1 * cos - x2 * sin, x2 * cos + x1 * sin], axis=-1).astype(x.dtype)


def sink_attention(q, k, v, mask, sinks):
    s = jnp.einsum('...qhgd,...khd->...hgqk', q, k, preferred_element_type=jnp.float32) * (HEAD_DIM ** -0.5)
    s = jnp.where(mask, s, NEG_INF)
    sink = jnp.broadcast_to(sinks.astype(jnp.float32).reshape(N_KV_HEADS, GROUP, 1, 1), s.shape[:-1] + (1,))
    p = jax.nn.softmax(jnp.concatenate([s, sink], axis=-1), axis=-1)[..., :-1]
    return jnp.einsum('...hgqk,...khd->...qhgd', p.astype(v.dtype), v)


def swa_band(q, k, v, sinks):
    B, L = q.shape[:2]
    blk = WINDOW
    nb = L // blk
    qb = q.reshape(B, nb, blk, N_KV_HEADS, GROUP, HEAD_DIM)

    def band(t):
        tb = jnp.pad(t, ((0, 0), (blk, 0), (0, 0), (0, 0))).reshape(B, nb + 1, blk, N_KV_HEADS, HEAD_DIM)
        return jnp.concatenate([tb[:, :-1], tb[:, 1:]], axis=2)

    kb, vb = band(k), band(v)
    qi = jnp.arange(blk)[:, None] + blk
    kj = jnp.arange(2 * blk)[None, :]
    rel = qi - kj
    in_window = (rel >= 0) & (rel < WINDOW)
    real_key = (jnp.arange(nb)[:, None, None] * blk + kj[None] - blk) >= 0
    mask = (in_window[None] & real_key)[:, None, None]
    o = sink_attention(qb, kb, vb, mask, sinks)
    return o.reshape(B, L, ATTN_Q)


def spatial_gating(u, vn, sg_w, sg_b, chunk):
    B, L, _ = u.shape
    nc = L // chunk
    u5 = u.reshape(B, nc, chunk, SG_GROUPS, SG_GROUP_DIM)
    v5 = vn.reshape(B, nc, chunk, SG_GROUPS, SG_GROUP_DIM)
    w = jnp.tril(sg_w[:, :chunk, :chunk])
    mixed = jnp.einsum('gts,bnsgc->bntgc', w, v5) + sg_b[:, :chunk].T[:, :, None]
    return (u5 * mixed).reshape(B, L, SG_WIDTH)


def memory_kv(mem, g, w_mem_kv):
    B = mem.shape[0]
    kv = jnp.einsum('bmd,de->bme', rms_norm(mem, g), w_mem_kv)
    k, v = jnp.split(kv, 2, axis=-1)
    return (k.reshape(B, -1, MEM_HEADS, MEM_HEAD_DIM), v.reshape(B, -1, MEM_HEADS, MEM_HEAD_DIM))


def mem_attention(q, mk, mv):
    s = jnp.einsum('blhd,bmhd->bhlm', q, mk, preferred_element_type=jnp.float32) * (MEM_HEAD_DIM ** -0.5)
    p = jax.nn.softmax(s, axis=-1)
    return jnp.einsum('bhlm,bmhd->blhd', p.astype(mv.dtype), mv)


def conv_ffn(h, conv_past, w_up, conv_w, conv_b, w_down):
    L = h.shape[1]
    up = jnp.einsum('bld,df->blf', h, w_up)
    ext = jnp.concatenate([conv_past.astype(up.dtype), up], axis=1)
    c = conv_b
    for j in range(CONV_WIDTH):
        c = c + ext[:, j:j + L] * conv_w[j]
    gate, val = jnp.split(c, 2, axis=-1)
    act = jax.nn.gelu(gate, approximate=True) * val
    return jnp.einsum('blf,fd->bld', act, w_down), ext[:, L:]


def decoder_layer(x, start, win_k, win_v, mem_k, mem_v, conv_past, lp):
    B, L, _ = x.shape
    pos = start + jnp.arange(L, dtype=jnp.int32)
    h = rms_norm(x, lp['pre_mix_g'])
    z = jnp.einsum('bld,de->ble', h, lp['w_in'])
    q, k, v, sg_u, sg_v, mq, gate_logits = jnp.split(z, IN_OFFSETS, axis=-1)
    q = rope(q.reshape(B, L, N_Q_HEADS, HEAD_DIM), pos).reshape(B, L, N_KV_HEADS, GROUP, HEAD_DIM)
    k = rope(k.reshape(B, L, N_KV_HEADS, HEAD_DIM), pos)
    v = v.reshape(B, L, N_KV_HEADS, HEAD_DIM)
    if win_k is None:
        attn = swa_band(q, k, v, lp['sinks'])
        wb = min(WINDOW, L)
        new_wk, new_wv = k[:, L - wb:], v[:, L - wb:]
        chunk = CHUNK
        conv_past = jnp.zeros((B, CONV_WIDTH - 1, 2 * D_FF), x.dtype)
    else:
        wb = win_k.shape[1]
        kk = jnp.concatenate([win_k.astype(k.dtype), k], axis=1)
        vv = jnp.concatenate([win_v.astype(v.dtype), v], axis=1)
        kpos = start - wb + jnp.arange(wb + L, dtype=jnp.int32)
        rel = pos[:, None] - kpos[None, :]
        mask = (rel >= 0) & (rel < WINDOW)
        attn = sink_attention(q, kk, vv, mask, lp['sinks']).reshape(B, L, ATTN_Q)
        new_wk, new_wv = kk[:, L:], vv[:, L:]
        chunk = L
    u = jax.nn.gelu(sg_u, approximate=False)
    vn = layer_norm(jax.nn.gelu(sg_v, approximate=False), lp['sg_ln_g'], lp['sg_ln_b'])
    sg = spatial_gating(u, vn, lp['sg_w'], lp['sg_b'], chunk)
    memo = mem_attention(mq.reshape(B, L, MEM_HEADS, MEM_HEAD_DIM), mem_k.astype(x.dtype), mem_v.astype(x.dtype))
    branches = jnp.stack([attn, sg, memo.reshape(B, L, MEM_Q)], axis=2)
    proj = jnp.einsum('blnc,ncd->blnd', branches, lp['w_o'])
    gates = jax.nn.sigmoid(gate_logits.reshape(B, L, N_BRANCHES, D_MODEL))
    mixed = jnp.sum(gates * proj, axis=2)
    x = x + rms_norm(mixed, lp['post_mix_g'])
    f, new_conv = conv_ffn(rms_norm(x, lp['pre_ffn_g']), conv_past, lp['w_up'], lp['conv_w'], lp['conv_b'], lp['w_down'])
    x = x + rms_norm(f, lp['post_ffn_g'])
    return x, new_wk, new_wv, vn, new_conv


def setup_inputs(seed: int = 0) -> dict:
    key = jax.random.key(seed)
    ks = jax.random.split(key, 32)
    f32 = jnp.float32
    wb = min(WINDOW, PAST_LEN)

    def nrm(k, shape, scale=1.0):
        return jax.random.normal(k, shape, f32) * scale

    def gain(k, shape):
        return 1.0 + 0.05 * jax.random.normal(k, shape, f32)

    return {
        'x_prompt': nrm(ks[0], (BATCH, SEQ, D_MODEL)),
        'x_sample': nrm(ks[1], (DEC_BATCH, DEC_SEQ, D_MODEL)),
        'cache_win_k': nrm(ks[2], (DEPTH, DEC_BATCH, wb, N_KV_HEADS, HEAD_DIM)),
        'cache_win_v': nrm(ks[3], (DEPTH, DEC_BATCH, wb, N_KV_HEADS, HEAD_DIM)),
        'cache_mem_k': nrm(ks[4], (DEPTH, DEC_BATCH, N_MEM, MEM_HEADS, MEM_HEAD_DIM)),
        'cache_mem_v': nrm(ks[5], (DEPTH, DEC_BATCH, N_MEM, MEM_HEADS, MEM_HEAD_DIM)),
        'state_conv': nrm(ks[6], (DEPTH, DEC_BATCH, CONV_WIDTH - 1, 2 * D_FF)),
        'mem_prompt': nrm(ks[7], (BATCH, N_MEM, D_MODEL)),
        'pre_mix_g': gain(ks[8], (DEPTH, D_MODEL)),
        'w_in': nrm(ks[9], (DEPTH, D_MODEL, IN_WIDTH), D_MODEL ** -0.5),
        'attn_sinks': nrm(ks[10], (DEPTH, N_Q_HEADS), 0.5),
        'sg_ln_g': gain(ks[11], (DEPTH, SG_WIDTH)),
        'sg_ln_b': nrm(ks[12], (DEPTH, SG_WIDTH), 0.02),
        'sg_w': nrm(ks[13], (DEPTH, SG_GROUPS, CHUNK, CHUNK), CHUNK ** -0.5),
        'sg_b': 1.0 + nrm(ks[14], (DEPTH, SG_GROUPS, CHUNK), 0.1),
        'mem_norm_g': gain(ks[15], (DEPTH, D_MODEL)),
        'w_mem_kv': nrm(ks[16], (DEPTH, D_MODEL, 2 * MEM_Q), D_MODEL ** -0.5),
        'w_o': nrm(ks[17], (DEPTH, N_BRANCHES, BRANCH_WIDTH, D_MODEL), BRANCH_WIDTH ** -0.5),
        'post_mix_g': gain(ks[18], (DEPTH, D_MODEL)),
        'pre_ffn_g': gain(ks[19], (DEPTH, D_MODEL)),
        'w_up': nrm(ks[20], (DEPTH, D_MODEL, 2 * D_FF), D_MODEL ** -0.5),
        'conv_w': nrm(ks[21], (DEPTH, CONV_WIDTH, 2 * D_FF), CONV_WIDTH ** -0.5),
        'conv_b': nrm(ks[22], (DEPTH, 2 * D_FF), 0.01),
        'w_down': nrm(ks[23], (DEPTH, D_FF, D_MODEL), D_FF ** -0.5),
        'post_ffn_g': gain(ks[24], (DEPTH, D_MODEL)),
    }


def reference(x_prompt, x_sample, cache_win_k, cache_win_v, cache_mem_k, cache_mem_v, state_conv, mem_prompt,
              pre_mix_g, w_in, attn_sinks, sg_ln_g, sg_ln_b, sg_w, sg_b, mem_norm_g, w_mem_kv, w_o,
              post_mix_g, pre_ffn_g, w_up, conv_w, conv_b, w_down, post_ffn_g):
    y_p, y_s = x_prompt, x_sample
    wk_p, wv_p, mk_p, mv_p, cv_p = [], [], [], [], []
    wk_s, wv_s, sgv_s, cv_s = [], [], [], []
    for l in range(DEPTH):
        lp = {
            'pre_mix_g': pre_mix_g[l], 'w_in': w_in[l], 'sinks': attn_sinks[l],
            'sg_ln_g': sg_ln_g[l], 'sg_ln_b': sg_ln_b[l], 'sg_w': sg_w[l], 'sg_b': sg_b[l],
            'w_o': w_o[l], 'post_mix_g': post_mix_g[l], 'pre_ffn_g': pre_ffn_g[l],
            'w_up': w_up[l], 'conv_w': conv_w[l], 'conv_b': conv_b[l], 'w_down': w_down[l],
            'post_ffn_g': post_ffn_g[l],
        }
        mem_k_l, mem_v_l = memory_kv(mem_prompt, mem_norm_g[l], w_mem_kv[l])
        y_p, a_k, a_v, _, a_c = decoder_layer(y_p, 0, None, None, mem_k_l, mem_v_l, None, lp)
        wk_p.append(a_k); wv_p.append(a_v); mk_p.append(mem_k_l); mv_p.append(mem_v_l); cv_p.append(a_c)
        y_s, b_k, b_v, b_sg, b_c = decoder_layer(y_s, PAST_LEN, cache_win_k[l], cache_win_v[l],
                                                 cache_mem_k[l], cache_mem_v[l], state_conv[l], lp)
        wk_s.append(b_k); wv_s.append(b_v); sgv_s.append(b_sg); cv_s.append(b_c)
    return (y_p, y_s,
            jnp.stack(wk_p), jnp.stack(wv_p), jnp.stack(mk_p), jnp.stack(mv_p), jnp.stack(cv_p),
            jnp.stack(wk_s), jnp.stack(wv_s), jnp.stack(sgv_s), jnp.stack(cv_s))
```

```cpp
#include <hip/hip_runtime.h>
#include <hip/hip_cooperative_groups.h>
#include <cstdio>
#include <cstdint>
#include <cmath>
namespace cg = cooperative_groups;

namespace pg8 {
#define PG8_LAS __attribute__((address_space(3)))
typedef unsigned short bf16_t;
typedef short bf16x8 __attribute__((ext_vector_type(8)));
typedef float f32x4 __attribute__((ext_vector_type(4)));
typedef unsigned u32x4 __attribute__((ext_vector_type(4)));
constexpr int BM = 256, BK = 64, HALF = 128, HTB = HALF * BK * 2  , STAGE_BYTES = 8 * HTB, NXCD = 8, WGM = 4;

__host__ __device__ __forceinline__ int lds_byte(int r, int c) { const int st = (r >> 4) * 2 + (c >> 5), rr = r & 15, cc = c & 31, ob = rr * 64 + cc * 2; return st * 1024 + (ob ^ (((ob >> 9) & 1) << 5)); }
__host__ __device__ __forceinline__ void stage_rc(int b, int& R, int& C) { const int st = b / 1024, sb = b % 1024, swz = sb ^ (((sb >> 9) & 1) << 5); R = (st >> 1) * 16 + swz / 64; C = (st & 1) * 32 + (swz % 64) / 2; }
__host__ __device__ __forceinline__ int perm32(int rho) { const int n = rho >> 4, i = rho & 15; return 8 * (i >> 2) + 4 * n + (i & 3); }

struct Unit { int pm, pn; };
struct Gemm { const bf16_t* A; const bf16_t* Bt; int M, N, K, lda, ldb, adiv, bmod, aperm; };
__device__ __forceinline__ int arow_of(const Gemm& g, int pm) { return g.aperm ? (pm < 65 ? 254 * pm - 2 : 16384 + 256 * (pm - 65)) : 256 * pm; }

struct StaticOrder {
    int nM, nN, nwg, G, c;
    __host__ __device__ void init(int M, int N, int G_, int c_) { nM = M / BM; nN = N / BM; nwg = nM * nN; G = G_; c = c_; }
    __host__ __device__ bool next(int i, Unit& u) const {
        const long L = (long)i * G + c; if (L >= nwg) return false;
        int wgid = (int)L; { const int q = nwg / NXCD, r = nwg % NXCD, xcd = wgid % NXCD, off = wgid / NXCD; wgid = (xcd < r ? xcd * (q + 1) : r * (q + 1) + (xcd - r) * q) + off; }
        const int nig = WGM * nN, gid = wgid / nig, fm = gid * WGM, gsz = (nM - fm) < WGM ? (nM - fm) : WGM;
        u.pm = fm + ((wgid % nig) % gsz); u.pn = (wgid % nig) / gsz; return true;
    }
    __device__ __forceinline__ void a_ready(const Unit&) const {}
    __device__ __forceinline__ void done(const Unit&) const {}
};
struct SplitOrder {
    int c, G;
    __device__ bool next(int i, Unit& u) const { if (i > 0 || c >= 176) return false; u.pm = 64 + c / 44; u.pn = c % 44; return true; }
    __device__ __forceinline__ void a_ready(const Unit&) const {}
    __device__ __forceinline__ void done(const Unit&) const {}
};
struct TripleOrder {
    StaticOrder so;
    __device__ bool next(int i, Unit& u) const { if (!so.next(i / 3, u)) return false; u.pn += 4 * (i % 3); return true; }
    __device__ __forceinline__ void a_ready(const Unit&) const {}
    __device__ __forceinline__ void done(const Unit&) const {}
};
struct SampleOrder {
    int c;
    __device__ bool next(int i, Unit& u) const { if (i > 0 || c >= 48) return false; u.pm = 64 + c / 12; u.pn = c % 12; return true; }
    __device__ __forceinline__ void a_ready(const Unit&) const {}
    __device__ __forceinline__ void done(const Unit&) const {}
};
struct RowListOrder {
    int c, cnt, pm0;
    __device__ bool next(int i, Unit& u) const { if (i > 0 || c < 0 || c >= cnt) return false; u.pm = pm0; u.pn = c; return true; }
    __device__ __forceinline__ void a_ready(const Unit&) const {}
    __device__ __forceinline__ void done(const Unit&) const {}
};

__device__ __forceinline__ unsigned cvt_pk_bf16(float lo, float hi) { unsigned r; asm volatile("v_cvt_pk_bf16_f32 %0, %1, %2" : "=v"(r) : "v"(lo), "v"(hi)); return r; }
typedef float f32x2 __attribute__((ext_vector_type(2)));
__device__ __forceinline__ f32x2 gelu_pk(f32x2 v) {
    const f32x2 av = __builtin_elementwise_abs(v), d = av * 0.2316418882f + 1.0f;
    f32x2 t; t.x = __builtin_amdgcn_rcpf(d.x); t.y = __builtin_amdgcn_rcpf(d.y);
    f32x2 q = t * 0.5307027145f + (-0.7265760135f); q = q * t + 0.7107068705f; q = q * t + (-0.142248368f); q = q * t + 0.127414796f; q = q * t;
    const f32x2 s = (v * v) * (-0.72134752044f);
    f32x2 e; e.x = __builtin_amdgcn_exp2f(s.x); e.y = __builtin_amdgcn_exp2f(s.y);
    const f32x2 m = v * (q * e), r = v - m;
    f32x2 o; o.x = v.x < 0.f ? m.x : r.x; o.y = v.y < 0.f ? m.y : r.y; return o;
}
__device__ __forceinline__ f32x4 gelu4(f32x4 v) { f32x2 a = gelu_pk((f32x2){v[0], v[1]}), b = gelu_pk((f32x2){v[2], v[3]}); return (f32x4){a.x, a.y, b.x, b.y}; }
__device__ __forceinline__ u32x4 pack8(f32x4 v0, f32x4 v1) { u32x4 w; w.x = cvt_pk_bf16(v0[0], v0[1]); w.y = cvt_pk_bf16(v0[2], v0[3]); w.z = cvt_pk_bf16(v1[0], v1[1]); w.w = cvt_pk_bf16(v1[2], v1[3]); return w; }

template <class Epi, class Sched, bool ALIGN_EPI = false, bool SP2 = false, bool CARRY = false>
__device__ __forceinline__ void gemm_phase(PG8_LAS unsigned char* lds, const Gemm g, const Sched& S, const Epi& E) {
    const int tid = threadIdx.x, wid = __builtin_amdgcn_readfirstlane(tid >> 6), lane = tid & 63, wr = wid >> 2, wc = wid & 3, fr = lane & 15, fq = lane >> 4;
    const int K = g.K, nt = K / BK;
    unsigned voffA[2], voffB[2];
#pragma unroll
    for (int i = 0; i < 2; ++i) { int R, C; stage_rc(tid * 16 + i * 8192, R, C); const int Rb = Epi::PERM ? ((R & ~31) + perm32(R & 31)) : R;
        const int Ra = g.aperm ? (8 * (16 * (R >> 6) + (R & 15)) + ((R >> 4) & 3)) : R; voffA[i] = (unsigned)(Ra * g.lda + C) * 2u; voffB[i] = (unsigned)(Rb * g.ldb + C) * 2u; }
    const size_t kstep = (size_t)(BK * 2);
    const size_t hstepA = (size_t)(g.aperm ? 4 : HALF) * g.lda * 2, hstepB = (size_t)HALF * g.ldb * 2;
    const size_t tstepB = 2 * hstepB;
    const unsigned ldsw = (unsigned)wid * 1024u;
    const int aoff = lds_byte(wr * 64 + fr, fq * 8), boff = lds_byte(wc * 32 + fr, fq * 8);
#define PG8_SA(b, h) (((b) * 2 + (h)) * HTB)
#define PG8_SB(b, h) ((4 + (b) * 2 + (h)) * HTB)
#define PG8_STAGE(bufoff, gbase, voff) do { _Pragma("unroll") for (int _i = 0; _i < 2; ++_i) \
        __builtin_amdgcn_global_load_lds((const unsigned*)((const char*)(gbase) + (voff)[_i]), (PG8_LAS unsigned*)(lds + (bufoff) + ldsw + _i * 8192), 16, 0, 0); } while (0)
#define PG8_LDA(dst, b, h) do { _Pragma("unroll") for (int m = 0; m < 4; ++m) _Pragma("unroll") for (int k = 0; k < 2; ++k) dst[m][k] = *(const PG8_LAS bf16x8*)(lds + PG8_SA(b, h) + aoff + m * 2048 + k * 1024); } while (0)
#define PG8_LDB(dst, b, h) do { _Pragma("unroll") for (int n = 0; n < 2; ++n) _Pragma("unroll") for (int k = 0; k < 2; ++k) dst[n][k] = *(const PG8_LAS bf16x8*)(lds + PG8_SB(b, h) + boff + n * 2048 + k * 1024); } while (0)
#define PG8_MMA(ai, bj, At, Bt) do { __builtin_amdgcn_s_setprio(1); _Pragma("unroll") for (int m = 0; m < 4; ++m) _Pragma("unroll") for (int n = 0; n < 2; ++n) _Pragma("unroll") for (int k = 0; k < 2; ++k) \
        acc[ai][bj][m][n] = __builtin_amdgcn_mfma_f32_16x16x32_bf16(Bt[n][k], At[m][k], acc[ai][bj][m][n], 0, 0, 0); __builtin_amdgcn_s_setprio(0); } while (0)
#define PG8_WAIT_V(n) asm volatile("s_waitcnt vmcnt(" #n ")" ::: "memory")
#define PG8_WAIT_L(n) asm volatile("s_waitcnt lgkmcnt(" #n ")" ::: "memory")
#define PG8_BAR __builtin_amdgcn_s_barrier()
#define PG8_SCHED __builtin_amdgcn_sched_barrier(0)
    Unit cur, nxt; int ui = 0;
    if (!S.next(0, cur)) return;
    f32x4 acc[2][2][4][2];
#pragma unroll
    for (int a = 0; a < 2; ++a)
#pragma unroll
        for (int b = 0; b < 2; ++b)
#pragma unroll
            for (int m = 0; m < 4; ++m)
#pragma unroll
                for (int n = 0; n < 2; ++n) acc[a][b][m][n] = (f32x4){0.f, 0.f, 0.f, 0.f};
    bf16x8 At[4][2], B0[2][2], B1[2][2];
    const char* cA = (const char*)g.A + (long)arow_of(g, cur.pm) * (long)(g.lda * 2) + (size_t)(cur.pn / g.adiv) * K * 2; const char* cB = (const char*)g.Bt + (size_t)(cur.pn % g.bmod) * tstepB + (size_t)(cur.pn / g.bmod) * K * 2;
    S.a_ready(cur);
    if constexpr (SP2) {
        PG8_STAGE(PG8_SB(0, 0), cB, voffB); PG8_STAGE(PG8_SB(0, 1), cB + hstepB, voffB); PG8_STAGE(PG8_SA(0, 0), cA, voffA); PG8_STAGE(PG8_SA(0, 1), cA + hstepA, voffA);
        if (wr == 1) PG8_BAR;
        PG8_WAIT_V(2); PG8_BAR;
        PG8_STAGE(PG8_SB(1, 0), cB + kstep, voffB); PG8_STAGE(PG8_SA(1, 0), cA + kstep, voffA); PG8_STAGE(PG8_SB(1, 1), cB + hstepB + kstep, voffB);
        PG8_WAIT_V(6); PG8_BAR;
    } else {
        PG8_STAGE(PG8_SB(0, 0), cB, voffB); PG8_STAGE(PG8_SA(0, 0), cA, voffA); PG8_STAGE(PG8_SB(0, 1), cB + hstepB, voffB); PG8_STAGE(PG8_SA(0, 1), cA + hstepA, voffA);
        if (wr == 1) PG8_BAR;
        PG8_WAIT_V(4); PG8_BAR;
        PG8_STAGE(PG8_SB(1, 0), cB + kstep, voffB); PG8_STAGE(PG8_SA(1, 0), cA + kstep, voffA); PG8_STAGE(PG8_SB(1, 1), cB + hstepB + kstep, voffB);
        PG8_WAIT_V(6); PG8_BAR;
    }
    for (;;) {
        const bool has_next = S.next(ui + 1, nxt);
        const char* nA = has_next ? (const char*)g.A + (long)arow_of(g, nxt.pm) * (long)(g.lda * 2) + (size_t)(nxt.pn / g.adiv) * K * 2 : cA; const char* nB = has_next ? (const char*)g.Bt + (size_t)(nxt.pn % g.bmod) * tstepB + (size_t)(nxt.pn / g.bmod) * K * 2 : cB;
        for (int t = 0; t < nt; t += 2) {
            const bool last = (t == nt - 2);
            const char* a1 = cA + (size_t)(t + 1) * kstep;
            const char* a2 = last ? nA : cA + (size_t)(t + 2) * kstep; const char* b2 = last ? nB : cB + (size_t)(t + 2) * kstep;
            const char* a3 = a2 + kstep; const char* b3 = b2 + kstep;
            if (last && has_next) S.a_ready(nxt);
            if constexpr (SP2) {
            PG8_LDB(B0, 0, 0); PG8_LDB(B1, 0, 1); PG8_SCHED; PG8_LDA(At, 0, 0); PG8_STAGE(PG8_SA(1, 1), a1 + hstepA, voffA);
            PG8_WAIT_V(8); PG8_WAIT_L(0); PG8_BAR; PG8_MMA(0, 0, At, B0); PG8_MMA(0, 1, At, B1); PG8_BAR; PG8_SCHED;
            PG8_LDA(At, 0, 1); PG8_STAGE(PG8_SB(0, 0), b2, voffB); PG8_STAGE(PG8_SB(0, 1), b2 + hstepB, voffB); PG8_STAGE(PG8_SA(0, 0), a2, voffA);
            PG8_WAIT_V(8); PG8_WAIT_L(0); PG8_BAR; PG8_MMA(1, 0, At, B0); PG8_MMA(1, 1, At, B1); PG8_BAR; PG8_SCHED;
            PG8_LDB(B0, 1, 0); PG8_LDB(B1, 1, 1); PG8_SCHED; PG8_LDA(At, 1, 0); PG8_STAGE(PG8_SA(0, 1), a2 + hstepA, voffA);
            PG8_WAIT_V(8); PG8_WAIT_L(0); PG8_BAR; PG8_MMA(0, 0, At, B0); PG8_MMA(0, 1, At, B1); PG8_BAR; PG8_SCHED;
            PG8_LDA(At, 1, 1); PG8_STAGE(PG8_SB(1, 0), b3, voffB); PG8_STAGE(PG8_SB(1, 1), b3 + hstepB, voffB); PG8_STAGE(PG8_SA(1, 0), a3, voffA);
            PG8_WAIT_V(8); PG8_WAIT_L(0); PG8_BAR; PG8_MMA(1, 0, At, B0); PG8_MMA(1, 1, At, B1); PG8_BAR; PG8_SCHED;
            } else {
            PG8_LDB(B0, 0, 0); PG8_SCHED; PG8_LDA(At, 0, 0); PG8_STAGE(PG8_SA(1, 1), a1 + hstepA, voffA);
            PG8_WAIT_L(8); PG8_BAR; PG8_WAIT_L(0); PG8_MMA(0, 0, At, B0); PG8_BAR; PG8_SCHED;
            PG8_LDB(B1, 0, 1); PG8_STAGE(PG8_SB(0, 0), b2, voffB);
            PG8_BAR; PG8_WAIT_L(0); PG8_MMA(0, 1, At, B1); PG8_BAR;
            PG8_LDA(At, 0, 1); PG8_STAGE(PG8_SA(0, 0), a2, voffA);
            PG8_BAR; PG8_WAIT_L(0); PG8_MMA(1, 0, At, B0); PG8_BAR; PG8_SCHED;
            PG8_STAGE(PG8_SB(0, 1), b2 + hstepB, voffB);
            PG8_WAIT_V(6); PG8_BAR; PG8_MMA(1, 1, At, B1); PG8_BAR;
            PG8_LDB(B0, 1, 0); PG8_SCHED; PG8_LDA(At, 1, 0); PG8_STAGE(PG8_SA(0, 1), a2 + hstepA, voffA);
            PG8_WAIT_L(8); PG8_BAR; PG8_WAIT_L(0); PG8_MMA(0, 0, At, B0); PG8_BAR; PG8_SCHED;
            PG8_LDB(B1, 1, 1); PG8_STAGE(PG8_SB(1, 0), b3, voffB);
            PG8_BAR; PG8_WAIT_L(0); PG8_MMA(0, 1, At, B1); PG8_BAR;
            PG8_LDA(At, 1, 1); PG8_STAGE(PG8_SA(1, 0), a3, voffA);
            PG8_BAR; PG8_WAIT_L(0); PG8_MMA(1, 0, At, B0); PG8_BAR; PG8_SCHED;
            PG8_STAGE(PG8_SB(1, 1), b3 + hstepB, voffB);
            PG8_WAIT_V(6); PG8_BAR; PG8_MMA(1, 1, At, B1); PG8_BAR;
            }
        }
        if constexpr (ALIGN_EPI) { if (wr == 0) PG8_BAR; }
        if constexpr (!Epi::AFTER_DRAIN) { E(acc, cur, wr, wc, fr, fq); S.done(cur); }
        if (!has_next) break;
        if (!(CARRY && cur.pn < 8))
#pragma unroll
        for (int a = 0; a < 2; ++a)
#pragma unroll
            for (int b = 0; b < 2; ++b)
#pragma unroll
                for (int m = 0; m < 4; ++m)
#pragma unroll
                    for (int n = 0; n < 2; ++n) acc[a][b][m][n] = (f32x4){0.f, 0.f, 0.f, 0.f};
        cur = nxt; cA = nA; cB = nB; ++ui;
        if constexpr (ALIGN_EPI) { if (wr == 1) PG8_BAR; }
    }
    PG8_WAIT_V(0);
    if constexpr (!ALIGN_EPI) { if (wr == 0) PG8_BAR; }
    PG8_BAR;
    if constexpr (Epi::AFTER_DRAIN) { E.fused(acc, cur, wr, wc, fr, fq, lds, wid, lane); S.done(cur); }
#undef PG8_SA
#undef PG8_SB
#undef PG8_STAGE
#undef PG8_LDA
#undef PG8_LDB
#undef PG8_MMA
#undef PG8_WAIT_V
#undef PG8_WAIT_L
#undef PG8_BAR
#undef PG8_SCHED
}

typedef unsigned short bf16;
typedef short s16x4 __attribute__((ext_vector_type(4)));
typedef unsigned u32x2 __attribute__((ext_vector_type(2)));
#define LAS PG8_LAS
constexpr int DMODEL = 1024, LP = 16384, MT = 17408, NZ = 5376, NBR = 1536, NUP = 5632, DFF = 2816;
constexpr int ZK = 512, ZV = 640, ZU = 768, ZSV = 1280, ZMQ = 1792, ZG = 2304;
constexpr float EPS = 1e-6f, LOG2E = 1.4426950408889634f;
constexpr size_t O_WKP = 17825792, O_WVP = O_WKP + 16384, O_MKP = O_WVP + 16384, O_MVP = O_MKP + 131072, O_CVP = O_MVP + 131072,
                 O_WKS = O_CVP + 11264, O_WVS = O_WKS + 2097152, O_SGS = O_WVS + 2097152, O_CVS = O_SGS + 524288, O_END = O_CVS + 1441792;
static_assert(O_END == 24292352, "output map");
constexpr size_t W_WIN = 0, W_WO = W_WIN + (size_t)NZ * 1024 * 2, W_WUP = W_WO + (size_t)3072 * 512 * 2, W_WDN = W_WUP + (size_t)NUP * 1024 * 2,
                 W_WMKV = W_WDN + (size_t)1024 * DFF * 2, W_ROPE = W_WMKV + (size_t)1024 * 1024 * 2, W_MEMN = W_ROPE + (size_t)16392 * 32 * 8,
                 W_MEMK = W_MEMN + (size_t)256 * 1024 * 2, W_MEMVT = W_MEMK + (size_t)256 * 512 * 2, W_HALO = W_MEMVT + (size_t)512 * 256 * 2,
                 W_XN = W_HALO + (size_t)272 * 2 * NUP * 2, W_Z = W_XN + (size_t)MT * 1024 * 2, W_PART = W_Z + (size_t)104857600, W_X1B = W_Z + (size_t)MT * NZ * 2, X1B_SPLIT = 5120, W_CTL = W_X1B + (size_t)(MT - X1B_SPLIT) * 2048, CTL_BYTES = 16384, W_END = W_CTL + CTL_BYTES;
static_assert((size_t)X1B_SPLIT * 2048 <= (size_t)NZ * 1024 * 2 && W_PART >= W_Z + (size_t)MT * DFF * 2 && W_PART + (size_t)11 * 1024 * 1024 * 2 <= W_X1B && W_X1B % 256 == 0 && W_CTL % 256 == 0, "ws map");
static_assert(W_Z % 256 == 0 && W_XN % 256 == 0 && W_HALO % 256 == 0, "ws alignment");
constexpr int LDS_BYTES = 163840, LDS_MISC = LDS_BYTES - 64;

__device__ __forceinline__ float bf2f(unsigned short b) { return __uint_as_float((unsigned)b << 16); }
__device__ __forceinline__ float bflo(unsigned w) { return __uint_as_float(w << 16); }
__device__ __forceinline__ float bfhi(unsigned w) { return __uint_as_float(w & 0xffff0000u); }
__device__ __forceinline__ unsigned short f2bf(float f) { unsigned u = __float_as_uint(f); return (unsigned short)((u + 0x7fffu + ((u >> 16) & 1u)) >> 16); }
__device__ __forceinline__ f32x4 bf4(const bf16* p) { const u32x2 w = *(const u32x2*)p; return (f32x4){bflo(w.x), bfhi(w.x), bflo(w.y), bfhi(w.y)}; }
__device__ __forceinline__ void unpack8(u32x4 w, f32x4& a, f32x4& b) { a = (f32x4){bflo(w.x), bfhi(w.x), bflo(w.y), bfhi(w.y)}; b = (f32x4){bflo(w.z), bfhi(w.z), bflo(w.w), bfhi(w.w)}; }
__device__ __forceinline__ u32x2 pack4(f32x4 v) { u32x2 w; w.x = cvt_pk_bf16(v[0], v[1]); w.y = cvt_pk_bf16(v[2], v[3]); return w; }
#define MK_DPPF(x, ctrl) __builtin_bit_cast(float, __builtin_amdgcn_update_dpp(0, __builtin_bit_cast(int, (x)), (ctrl), 0xf, 0xf, true))
__device__ __forceinline__ float wave_sum(float v) {
    v += MK_DPPF(v, 0xB1);
    v += MK_DPPF(v, 0x4E);
    v += MK_DPPF(v, 0x141);
    v += MK_DPPF(v, 0x140);
    const int iv = __builtin_bit_cast(int, v);
    const float r0 = __builtin_bit_cast(float, __builtin_amdgcn_readlane(iv, 0)), r1 = __builtin_bit_cast(float, __builtin_amdgcn_readlane(iv, 16));
    const float r2 = __builtin_bit_cast(float, __builtin_amdgcn_readlane(iv, 32)), r3 = __builtin_bit_cast(float, __builtin_amdgcn_readlane(iv, 48));
    return (r0 + r1) + (r2 + r3);
}
__device__ __forceinline__ float sigmoidf_(float x) { return __builtin_amdgcn_rcpf(1.f + __builtin_amdgcn_exp2f(-LOG2E * x)); }
__device__ __forceinline__ f32x4 sigmoid4(f32x4 v) {
    const f32x4 t = v * (-LOG2E);
    f32x4 e; e[0] = __builtin_amdgcn_exp2f(t[0]); e[1] = __builtin_amdgcn_exp2f(t[1]); e[2] = __builtin_amdgcn_exp2f(t[2]); e[3] = __builtin_amdgcn_exp2f(t[3]);
    const f32x4 d = e + 1.0f;
    return (f32x4){__builtin_amdgcn_rcpf(d[0]), __builtin_amdgcn_rcpf(d[1]), __builtin_amdgcn_rcpf(d[2]), __builtin_amdgcn_rcpf(d[3])};
}
__device__ __forceinline__ float gelu_tanh(float x) { const float p = __builtin_fmaf(x * x, -0.10294324f, -2.3022082f); return x * __builtin_amdgcn_rcpf(1.f + __builtin_amdgcn_exp2f(x * p)); }

struct EpiZ {
    static constexpr bool PERM = true, AFTER_DRAIN = false;
    bf16* Z; const float* rope; float* out;
    __device__ __forceinline__ void operator()(const f32x4 (&acc)[2][2][4][2], const Unit& u, int wr, int wc, int fr, int fq) const {
        const int pn = u.pn;
#pragma unroll
        for (int ai = 0; ai < 2; ++ai)
#pragma unroll
            for (int m = 0; m < 4; ++m) {
                const int r = u.pm * BM + ai * HALF + wr * 64 + m * 16 + fr;
                bf16* zrow = Z + (size_t)r * NZ;
#pragma unroll
                for (int bj = 0; bj < 2; ++bj) {
                    const int c0 = pn * BM + bj * HALF + wc * 32 + 8 * fq;
                    f32x4 v0 = acc[ai][bj][m][0], v1 = acc[ai][bj][m][1];
                    if (pn < 2 || (pn == 2 && bj == 0)) {
                        const int pos = r < LP ? r : LP + ((r - LP) & 7);
                        const int i0 = (c0 & 63) >> 1;
                        const float* tp = rope + ((size_t)pos * 32 + i0) * 2;
                        const f32x4 t0 = *(const f32x4*)tp, t1 = *(const f32x4*)(tp + 4);
                        f32x4 o0, o1;
                        o0[0] = v0[0] * t0[0] - v0[1] * t0[1]; o0[1] = v0[1] * t0[0] + v0[0] * t0[1];
                        o0[2] = v0[2] * t0[2] - v0[3] * t0[3]; o0[3] = v0[3] * t0[2] + v0[2] * t0[3];
                        o1[0] = v1[0] * t1[0] - v1[1] * t1[1]; o1[1] = v1[1] * t1[0] + v1[0] * t1[1];
                        o1[2] = v1[2] * t1[2] - v1[3] * t1[3]; o1[3] = v1[3] * t1[2] + v1[2] * t1[3];
                        if (pn < 2) { o0 = o0 * 0.125f; o1 = o1 * 0.125f; }
                        else {
                            const int kvh = (c0 >> 6) & 1;
                            float* dst = nullptr;
                            if (r >= LP - 128 && r < LP) dst = out + O_WKP + (size_t)(r - (LP - 128)) * 128 + kvh * 64;
                            else if (r >= LP) dst = out + O_WKS + ((size_t)((r - LP) >> 3) * 128 + 120 + ((r - LP) & 7)) * 128 + kvh * 64;
                            if (dst) { *(f32x4*)(dst + i0) = (f32x4){o0[0], o0[2], o1[0], o1[2]}; *(f32x4*)(dst + 32 + i0) = (f32x4){o0[1], o0[3], o1[1], o1[3]}; }
                        }
                        v0 = o0; v1 = o1;
                    } else if (pn == 2) {
                        const int kvh = (c0 >> 6) & 1, d0 = c0 & 63;
                        float* dst = nullptr;
                        if (r >= LP - 128 && r < LP) dst = out + O_WVP + (size_t)(r - (LP - 128)) * 128 + kvh * 64;
                        else if (r >= LP) dst = out + O_WVS + ((size_t)((r - LP) >> 3) * 128 + 120 + ((r - LP) & 7)) * 128 + kvh * 64;
                        if (dst) { *(f32x4*)(dst + d0) = v0; *(f32x4*)(dst + d0 + 4) = v1; }
                    } else if (pn < 7) { v0 = gelu4(v0); v1 = gelu4(v1); }
                    else if (pn < 9) { v0 = v0 * 0.08838834764831845f; v1 = v1 * 0.08838834764831845f; }
                    else { v0 = sigmoid4(v0); v1 = sigmoid4(v1); }
                    *(u32x4*)(zrow + c0) = pack8(v0, v1);
                }
            }
    }
};
struct EpiMemKV {
    static constexpr bool PERM = true, AFTER_DRAIN = false;
    bf16* MK; bf16* MVT; float* out;
    __device__ __forceinline__ void operator()(const f32x4 (&acc)[2][2][4][2], const Unit& u, int wr, int wc, int fr, int fq) const {
#pragma unroll
        for (int ai = 0; ai < 2; ++ai)
#pragma unroll
            for (int m = 0; m < 4; ++m) {
                const int r = ai * HALF + wr * 64 + m * 16 + fr;
#pragma unroll
                for (int bj = 0; bj < 2; ++bj) {
                    const int c0 = u.pn * BM + bj * HALF + wc * 32 + 8 * fq;
                    const f32x4 v0 = acc[ai][bj][m][0], v1 = acc[ai][bj][m][1];
                    if (c0 < 512) {
                        float* dst = out + O_MKP + (size_t)r * 512 + c0; *(f32x4*)dst = v0; *(f32x4*)(dst + 4) = v1;
                        *(u32x4*)(MK + (size_t)r * 512 + c0) = pack8(v0, v1);
                    } else {
                        const int cv = c0 - 512;
                        float* dst = out + O_MVP + (size_t)r * 512 + cv; *(f32x4*)dst = v0; *(f32x4*)(dst + 4) = v1;
                        *(u32x4*)(MVT + (size_t)r * 512 + cv) = pack8(v0, v1);
                    }
                }
            }
    }
};
struct EpiGate {
    static constexpr bool PERM = true, AFTER_DRAIN = false;
    bf16* Z; int dry;
    __device__ __forceinline__ void operator()(const f32x4 (&acc)[2][2][4][2], const Unit& u, int wr, int wc, int fr, int fq) const {
        bf16* p0 = Z + (size_t)(u.pm * BM + wr * 64 + fr) * NZ + ZG + u.pn * BM + wc * 32 + 8 * fq;
        u32x4 gt[2][4][2];
#pragma unroll
        for (int ai = 0; ai < 2; ++ai)
#pragma unroll
            for (int m = 0; m < 4; ++m)
#pragma unroll
                for (int bj = 0; bj < 2; ++bj) gt[ai][m][bj] = *(const u32x4*)(p0 + (size_t)(ai * HALF + m * 16) * NZ + bj * HALF);
#pragma unroll
        for (int ai = 0; ai < 2; ++ai)
#pragma unroll
            for (int m = 0; m < 4; ++m)
#pragma unroll
                for (int bj = 0; bj < 2; ++bj) {
                    f32x4 g0, g1; unpack8(gt[ai][m][bj], g0, g1);
                    const u32x4 w = pack8(acc[ai][bj][m][0] * g0, acc[ai][bj][m][1] * g1);
                    if (!dry) *(u32x4*)(p0 + (size_t)(ai * HALF + m * 16) * NZ + bj * HALF) = w;
                }
    }
};
struct EpiGate3 {
    static constexpr bool PERM = true, AFTER_DRAIN = false;
    bf16* Z;
    __device__ __forceinline__ void operator()(f32x4 (&acc)[2][2][4][2], const Unit& u, int wr, int wc, int fr, int fq) const {
        const int n = u.pn >> 2, pnc = u.pn & 3;
        bf16* p0 = Z + (size_t)(u.pm * BM + wr * 64 + fr) * NZ + ZG + pnc * BM + wc * 32 + 8 * fq;
        if (n < 2) {
#pragma unroll
            for (int ai = 0; ai < 2; ++ai) {
                u32x4 ga[4][2], gb[4][2];
#pragma unroll
                for (int m = 0; m < 4; ++m)
#pragma unroll
                    for (int bj = 0; bj < 2; ++bj) { const bf16* p = p0 + (size_t)(ai * HALF + m * 16) * NZ + bj * HALF + n * 1024; ga[m][bj] = *(const u32x4*)p; gb[m][bj] = *(const u32x4*)(p + 1024); }
#pragma unroll
                for (int m = 0; m < 4; ++m)
#pragma unroll
                    for (int bj = 0; bj < 2; ++bj) {
                        f32x4 a0, a1, b0, b1; unpack8(ga[m][bj], a0, a1); unpack8(gb[m][bj], b0, b1);
#pragma unroll
                        for (int e = 0; e < 4; ++e) {
                            acc[ai][bj][m][0][e] *= fmaxf(a0[e], 1e-30f) * __builtin_amdgcn_rcpf(fmaxf(b0[e], 1e-30f));
                            acc[ai][bj][m][1][e] *= fmaxf(a1[e], 1e-30f) * __builtin_amdgcn_rcpf(fmaxf(b1[e], 1e-30f));
                        }
                    }
            }
        } else {
            u32x4 gt[2][4][2];
#pragma unroll
            for (int ai = 0; ai < 2; ++ai)
#pragma unroll
                for (int m = 0; m < 4; ++m)
#pragma unroll
                    for (int bj = 0; bj < 2; ++bj) gt[ai][m][bj] = *(const u32x4*)(p0 + (size_t)(ai * HALF + m * 16) * NZ + bj * HALF + 2048);
#pragma unroll
            for (int ai = 0; ai < 2; ++ai)
#pragma unroll
                for (int m = 0; m < 4; ++m)
#pragma unroll
                    for (int bj = 0; bj < 2; ++bj) {
                        f32x4 g0, g1; unpack8(gt[ai][m][bj], g0, g1);
#pragma unroll
                        for (int e = 0; e < 4; ++e) { g0[e] = fmaxf(g0[e], 1e-30f); g1[e] = fmaxf(g1[e], 1e-30f); }
                        *(u32x4*)(p0 + (size_t)(ai * HALF + m * 16) * NZ + bj * HALF + 2048) = pack8(acc[ai][bj][m][0] * g0, acc[ai][bj][m][1] * g1);
                    }
        }
    }
};
struct EpiPart {
    static constexpr bool PERM = true, AFTER_DRAIN = false;
    bf16* P;
    __device__ __forceinline__ void operator()(const f32x4 (&acc)[2][2][4][2], const Unit& u, int wr, int wc, int fr, int fq) const {
        const int ks = u.pn >> 2, ct = u.pn & 3;
#pragma unroll
        for (int ai = 0; ai < 2; ++ai)
#pragma unroll
            for (int m = 0; m < 4; ++m) {
                const int r = (u.pm - 64) * BM + ai * HALF + wr * 64 + m * 16 + fr;
#pragma unroll
                for (int bj = 0; bj < 2; ++bj) {
                    const int c0 = ct * BM + bj * HALF + wc * 32 + 8 * fq;
                    *(u32x4*)(P + ((size_t)ks * 1024 + r) * 1024 + c0) = pack8(acc[ai][bj][m][0], acc[ai][bj][m][1]);
                }
            }
    }
};
__device__ __forceinline__ f32x4 gelu_tanh4(f32x4 v) { return (f32x4){gelu_tanh(v[0]), gelu_tanh(v[1]), gelu_tanh(v[2]), gelu_tanh(v[3])}; }
__device__ __forceinline__ float MK_SHR1(float x) { const int xi = __builtin_bit_cast(int, x); return __builtin_bit_cast(float, __builtin_amdgcn_update_dpp(xi, xi, 0x111, 0xf, 0xf, false)); }
struct EpiConv {
    static constexpr bool PERM = true, AFTER_DRAIN = false;
    bf16* ACT; const float* cw; const float* cb; const float* sc; float* out; LAS float* xl;
    __device__ __forceinline__ void operator()(const f32x4 (&acc)[2][2][4][2], const Unit& u, int wr, int wc, int fr, int fq) const {
        const bool smp = u.pm >= 65;
        const int tau0 = 8 * (16 * wr + fr);
        const int t0 = smp ? LP + 256 * (u.pm - 65) + tau0 : 254 * u.pm - 2 + tau0;
        const int f0 = 128 * u.pn + 32 * wc + 8 * fq;
        f32x4 wg[3], wv[3], bg, bv;
#define MK_CONV_W(n_) do { _Pragma("unroll") for (int j3 = 0; j3 < 3; ++j3) { wg[j3] = *(const f32x4*)(cw + (size_t)j3 * NUP + f0 + 4 * (n_)); wv[j3] = *(const f32x4*)(cw + (size_t)j3 * NUP + DFF + f0 + 4 * (n_)); } \
        bg = *(const f32x4*)(cb + f0 + 4 * (n_)); bv = *(const f32x4*)(cb + DFF + f0 + 4 * (n_)); } while (0)
        MK_CONV_W(0);
        if (!smp) {
            if (wr == 0 && fr == 15) {
#pragma unroll
                for (int jj = 0; jj < 2; ++jj)
#pragma unroll
                    for (int bj = 0; bj < 2; ++bj)
#pragma unroll
                        for (int n = 0; n < 2; ++n) *(LAS f32x4*)(xl + ((((wc * 4 + fq) * 2 + jj) * 2 + bj) * 2 + n) * 4) = acc[1][bj][2 + jj][n];
            }
            asm volatile("s_waitcnt lgkmcnt(0)" ::: "memory"); __builtin_amdgcn_s_barrier(); asm volatile("" ::: "memory");
        }
        u32x2 keep[8];
#pragma unroll
        for (int n = 0; n < 2; ++n) {
            const int fc = f0 + 4 * n;
            if (n == 1) MK_CONV_W(1);
            f32x4 g2, g1, v2, v1;
            if (smp) {
                const float* p = sc + (size_t)((t0 - LP) >> 3) * 2 * NUP;
                g2 = *(const f32x4*)(p + fc); v2 = *(const f32x4*)(p + DFF + fc); g1 = *(const f32x4*)(p + NUP + fc); v1 = *(const f32x4*)(p + NUP + DFF + fc);
            } else {
#pragma unroll
                for (int e = 0; e < 4; ++e) {
                    g2[e] = MK_SHR1(acc[1][0][2][n][e]); g1[e] = MK_SHR1(acc[1][0][3][n][e]);
                    v2[e] = MK_SHR1(acc[1][1][2][n][e]); v1[e] = MK_SHR1(acc[1][1][3][n][e]);
                }
                if (fr == 0) {
                    if (wr == 1) {
                        const LAS float* xp = xl + (wc * 4 + fq) * 32 + n * 4;
                        g2 = *(const LAS f32x4*)(xp); v2 = *(const LAS f32x4*)(xp + 8); g1 = *(const LAS f32x4*)(xp + 16); v1 = *(const LAS f32x4*)(xp + 24);
                    } else { g2 = (f32x4){0.f, 0.f, 0.f, 0.f}; g1 = g2; v2 = g2; v1 = g2; }
                }
            }
#pragma unroll
            for (int j = 0; j < 8; ++j) {
                f32x4 ug = acc[j >> 2][0][j & 3][n], uv = acc[j >> 2][1][j & 3][n];
                if (!smp && u.pm == 0 && wr == 0 && fr == 0 && j < 2) { ug = (f32x4){0.f, 0.f, 0.f, 0.f}; uv = ug; }
                const f32x4 cgv = bg + wg[0] * g2 + wg[1] * g1 + wg[2] * ug;
                const f32x4 cvv = bv + wv[0] * v2 + wv[1] * v1 + wv[2] * uv;
                const f32x4 a = gelu_tanh4(cgv) * cvv;
                g2 = g1; g1 = ug; v2 = v1; v1 = uv;
                const int t = t0 + j;
                const bool ok = smp || (!(wr == 0 && fr == 0 && j < 2) && t < LP);
                const u32x2 pk = pack4(a);
                if (n == 0) keep[j] = pk;
                else if (ok) { u32x4 w; w.x = keep[j].x; w.y = keep[j].y; w.z = pk.x; w.w = pk.y; *(u32x4*)(ACT + (size_t)t * DFF + f0) = w; }
                if (smp) {
                    if (j >= 6) { float* dst = out + O_CVS + ((size_t)((t0 - LP) >> 3) * 2 + (j - 6)) * NUP; *(f32x4*)(dst + fc) = ug; *(f32x4*)(dst + DFF + fc) = uv; }
                } else if (t >= LP - 2 && t < LP) { float* dst = out + O_CVP + (size_t)(t - (LP - 2)) * NUP; *(f32x4*)(dst + fc) = ug; *(f32x4*)(dst + DFF + fc) = uv; }
            }
        }
    }
};
template <bool WITH_HALO> struct EpiStore {
    static constexpr bool PERM = true, AFTER_DRAIN = false;
    bf16* C; int ldc; bf16* halo;
    __device__ __forceinline__ void operator()(const f32x4 (&acc)[2][2][4][2], const Unit& u, int wr, int wc, int fr, int fq) const {
#pragma unroll
        for (int ai = 0; ai < 2; ++ai)
#pragma unroll
            for (int m = 0; m < 4; ++m) {
                const int r = u.pm * BM + ai * HALF + wr * 64 + m * 16 + fr;
#pragma unroll
                for (int bj = 0; bj < 2; ++bj) {
                    const int c0 = u.pn * BM + bj * HALF + wc * 32 + 8 * fq;
                    const u32x4 w = pack8(acc[ai][bj][m][0], acc[ai][bj][m][1]);
                    *(u32x4*)(C + (size_t)r * ldc + c0) = w;
                    if (WITH_HALO && m == 3 && fr >= 14 && r < LP) *(u32x4*)(halo + ((size_t)(r >> 6) * 2 + (r & 1)) * ldc + c0) = w;
                }
            }
    }
};

__device__ __forceinline__ void transpose_item(const float* W, int K, int N, bf16* WT, int row_off, bool qkperm, LAS float* scr, int item, int lane) {
    const int nblk = N / 32, kb = item / nblk, nb = item % nblk, k0 = 64 * kb, n0 = 32 * nb;
#pragma unroll 8
    for (int i = 0; i < 32; ++i) { const int kk = 2 * i + (lane >> 5); scr[kk * 33 + (lane & 31)] = W[(size_t)(k0 + kk) * N + n0 + (lane & 31)]; }
    asm volatile("s_waitcnt lgkmcnt(0)" ::: "memory");
    const int c = lane & 7;
#pragma unroll
    for (int j = 0; j < 4; ++j) {
        const int n = (lane >> 3) + 8 * j; const LAS float* s = scr + (8 * c) * 33 + n;
        u32x4 o; o.x = cvt_pk_bf16(s[0 * 33], s[1 * 33]); o.y = cvt_pk_bf16(s[2 * 33], s[3 * 33]); o.z = cvt_pk_bf16(s[4 * 33], s[5 * 33]); o.w = cvt_pk_bf16(s[6 * 33], s[7 * 33]);
        int ns = n0 + n; if (qkperm && ns < 640) ns = (ns & ~63) | ((ns & 31) << 1) | ((ns >> 5) & 1);
        if (N == NUP) { const int bj = ns >= DFF ? 1 : 0, f = ns - DFF * bj; ns = ((f >> 7) << 8) + (bj << 7) + (f & 127); }
        *(u32x4*)(WT + (size_t)(row_off + ns) * K + k0 + 8 * c) = o;
    }
    asm volatile("s_waitcnt lgkmcnt(0)" ::: "memory");
}
__device__ __forceinline__ void rms_row_to_bf16(const float* xrow, const float* g, bf16* orow, int lane) {
    const f32x4* xr = (const f32x4*)xrow + lane; f32x4 v[4]; float s = 0.f;
#pragma unroll
    for (int j = 0; j < 4; ++j) { v[j] = xr[64 * j]; s += (v[j][0] * v[j][0] + v[j][1] * v[j][1]) + (v[j][2] * v[j][2] + v[j][3] * v[j][3]); }
    const float r = 1.0f / sqrtf(wave_sum(s) * (1.f / 1024.f) + EPS);
#pragma unroll
    for (int j = 0; j < 4; ++j) { const f32x4 gv = ((const f32x4*)g)[64 * j + lane]; *(u32x2*)(orow + 4 * lane + 256 * j) = pack4(v[j] * r * gv); }
}

typedef short v4i16_t __attribute__((ext_vector_type(4)));
__device__ __forceinline__ s16x4 vtr(const LAS bf16* p) { return __builtin_bit_cast(s16x4, __builtin_amdgcn_ds_read_tr16_b64_v4i16((LAS v4i16_t*)p)); }
struct MaskBand { int lo, hi; __device__ __forceinline__ bool operator()(int key) const { return key >= lo && key <= hi; } };
struct MaskNone { __device__ __forceinline__ bool operator()(int) const { return true; } };

template <int D, int NKB, bool SINK, class Mask>
__device__ __forceinline__ void attn_rowblock(const bf16x8 (&qf)[D / 32], const LAS bf16* Kl, int ldk, const LAS bf16* Vt, int ldv, int key0, const Mask mask, float sink,
                                              f32x4 (&o)[D / 16], int fr, int fq) {
    f32x4 s[NKB];
#pragma unroll
    for (int cb = 0; cb < NKB; ++cb) {
        s[cb] = (f32x4){0.f, 0.f, 0.f, 0.f};
#pragma unroll
        for (int kc = 0; kc < D / 32; ++kc) {
            const bf16x8 kf = *(const LAS bf16x8*)(Kl + (key0 + 16 * cb + fr) * ldk + kc * 32 + 8 * fq);
            s[cb] = __builtin_amdgcn_mfma_f32_16x16x32_bf16(kf, qf[kc], s[cb], 0, 0, 0);
        }
    }
    float mx = -1e30f;
#pragma unroll
    for (int cb = 0; cb < NKB; ++cb)
#pragma unroll
        for (int e = 0; e < 4; ++e) { const bool ok = mask(key0 + 16 * cb + 4 * fq + e); const float v = ok ? s[cb][e] : -1e30f; s[cb][e] = v; mx = fmaxf(mx, v); }
    mx = fmaxf(mx, __shfl_xor(mx, 16)); mx = fmaxf(mx, __shfl_xor(mx, 32));
    if (SINK) mx = fmaxf(mx, sink);
    float l = 0.f;
#pragma unroll
    for (int cb = 0; cb < NKB; ++cb)
#pragma unroll
        for (int e = 0; e < 4; ++e) { const float p = __builtin_amdgcn_exp2f((s[cb][e] - mx) * LOG2E); s[cb][e] = p; l += p; }
    l += __shfl_xor(l, 16); l += __shfl_xor(l, 32);
    if (SINK) l += __builtin_amdgcn_exp2f((sink - mx) * LOG2E);
    const float inv = 1.0f / l;
#pragma unroll
    for (int db = 0; db < D / 16; ++db) o[db] = (f32x4){0.f, 0.f, 0.f, 0.f};
#pragma unroll
    for (int kc2 = 0; kc2 < NKB / 2; ++kc2) {
        const u32x4 pw = pack8(s[2 * kc2], s[2 * kc2 + 1]);
        const bf16x8 pf = __builtin_bit_cast(bf16x8, pw);
#pragma unroll
        for (int db = 0; db < D / 16; ++db) {
            const LAS bf16* vp = Vt + (key0 + 32 * kc2 + 4 * fq + (fr >> 2)) * ldv + 16 * db + 4 * (fr & 3);
            const s16x4 v0 = vtr(vp), v1 = vtr(vp + 16 * ldv);
            const bf16x8 vf = __builtin_shufflevector(v0, v1, 0, 1, 2, 3, 4, 5, 6, 7);
            o[db] = __builtin_amdgcn_mfma_f32_16x16x32_bf16(vf, pf, o[db], 0, 0, 0);
        }
    }
#pragma unroll
    for (int db = 0; db < D / 16; ++db) o[db] = o[db] * inv;
}

__device__ __forceinline__ void scatter8(LAS bf16* Vt, int ld, int d0, int j, u32x4 w) {
#pragma unroll
    for (int e = 0; e < 8; ++e) { const unsigned x = e < 2 ? w.x : e < 4 ? w.y : e < 6 ? w.z : w.w; Vt[(d0 + e) * ld + j] = (bf16)((e & 1) ? (x >> 16) : (x & 0xffffu)); }
}

__device__ __forceinline__ void p2_swa_prompt(LAS unsigned char* lds, const bf16* Z, bf16* BR, const float* sinks, int item, int tid, int wave, int lane) {
    const int blk = item >> 1, kvh = item & 1, fr = lane & 15, fq = lane >> 4;
    LAS bf16* Kl = (LAS bf16*)lds; LAS bf16* Vt = (LAS bf16*)(lds + 256 * 80 * 2);
    bf16x8 qfa[4][2];
#pragma unroll
    for (int q = 0; q < 4; ++q) {
        const int rb = wave * 4 + q, g = rb >> 3, ib = rb & 7;
#pragma unroll
        for (int kc = 0; kc < 2; ++kc) qfa[q][kc] = *(const bf16x8*)(Z + (size_t)(blk * 128 + ib * 16 + fr) * NZ + (kvh * 4 + g) * 64 + kc * 32 + 8 * fq);
    }
    {
        u32x4 kv[4], vv[4];
#pragma unroll
        for (int u = 0; u < 4; ++u) {
            const int idx = tid + u * 512, j = idx >> 3, ch = idx & 7, row = (blk - 1) * 128 + j;
            kv[u] = (u32x4){0u, 0u, 0u, 0u}; vv[u] = kv[u];
            if (row >= 0) { const bf16* zr = Z + (size_t)row * NZ + kvh * 64 + ch * 8; kv[u] = *(const u32x4*)(zr + ZK); vv[u] = *(const u32x4*)(zr + ZV); }
        }
        __syncthreads();
#pragma unroll
        for (int u = 0; u < 4; ++u) {
            const int idx = tid + u * 512, j = idx >> 3, ch = idx & 7;
            *(LAS u32x4*)(Kl + j * 80 + ch * 8) = kv[u];
            *(LAS u32x4*)(Vt + j * 80 + ch * 8) = vv[u];
        }
    }
    __syncthreads();
#pragma unroll
    for (int q = 0; q < 4; ++q) {
        const int rb = wave * 4 + q, g = rb >> 3, ib = rb & 7, head = kvh * 4 + g;
        const int qrow = blk * 128 + ib * 16 + fr;
        bf16x8 qf[2]; qf[0] = qfa[q][0]; qf[1] = qfa[q][1];
        const int key0 = 16 * (ib < 6 ? ib : 6), i = ib * 16 + fr;
        MaskBand mk; mk.lo = i + 1; mk.hi = i + 128; if (blk == 0 && mk.lo < 128) mk.lo = 128;
        f32x4 o[4];
        attn_rowblock<64, 10, true, MaskBand>(qf, Kl, 80, Vt, 80, key0, mk, sinks[head], o, fr, fq);
#pragma unroll
        for (int db = 0; db < 4; ++db) *(u32x2*)(BR + (size_t)qrow * NBR + head * 64 + 16 * db + 4 * fq) = pack4(o[db]);
    }
}
__device__ __forceinline__ void p2_swa_sample(LAS unsigned char* lds, const bf16* Z, bf16* BR, const float* sinks, const float* cwk, const float* cwv, float* out, int item, int tid, int wave, int lane) {
    const int b = item >> 1, kvh = item & 1, fr = lane & 15, fq = lane >> 4;
    LAS bf16* Kl = (LAS bf16*)lds; LAS bf16* Vt = (LAS bf16*)(lds + 256 * 80 * 2);
    const int g = wave * 2 + (fr >> 3), t = fr & 7, head = kvh * 4 + g, qrow = LP + b * 8 + t;
    bf16x8 qf[2];
    if (wave < 2) {
#pragma unroll
        for (int kc = 0; kc < 2; ++kc) qf[kc] = *(const bf16x8*)(Z + (size_t)qrow * NZ + head * 64 + kc * 32 + 8 * fq);
    }
    f32x4 ca[2], cc[2], cv0[2], cv1[2];
#pragma unroll
    for (int u = 0; u < 2; ++u) {
        const int idx = tid + u * 512, j = idx >> 3, ch = idx & 7;
        const size_t so = (((size_t)b * 128 + j) * 2 + kvh) * 64;
        const float* sk = cwk + so; const float* sv = cwv + so;
        ca[u] = __builtin_nontemporal_load((const f32x4*)(sk + 4 * ch)); cc[u] = __builtin_nontemporal_load((const f32x4*)(sk + 32 + 4 * ch));
        cv0[u] = __builtin_nontemporal_load((const f32x4*)(sv + 4 * ch)); cv1[u] = __builtin_nontemporal_load((const f32x4*)(sv + 32 + 4 * ch));
    }
    u32x4 kz = (u32x4){0u, 0u, 0u, 0u}, vz = kz;
    if (tid < 256 && ((tid + 1024) >> 3) < 136) {
        const int j = (tid + 1024) >> 3, ch = tid & 7;
        const bf16* zr = Z + (size_t)(LP + b * 8 + (j - 128)) * NZ + kvh * 64 + ch * 8; kz = *(const u32x4*)(zr + ZK); vz = *(const u32x4*)(zr + ZV);
    }
    __syncthreads();
#pragma unroll
    for (int u = 0; u < 2; ++u) {
        const int idx = tid + u * 512, j = idx >> 3, ch = idx & 7;
        u32x4 kv; kv.x = cvt_pk_bf16(ca[u][0], cc[u][0]); kv.y = cvt_pk_bf16(ca[u][1], cc[u][1]); kv.z = cvt_pk_bf16(ca[u][2], cc[u][2]); kv.w = cvt_pk_bf16(ca[u][3], cc[u][3]);
        *(LAS u32x4*)(Kl + j * 80 + ch * 8) = kv;
        *(LAS u32x2*)(Vt + j * 80 + ch * 4) = pack4(cv0[u]); *(LAS u32x2*)(Vt + j * 80 + 32 + ch * 4) = pack4(cv1[u]);
        if (j >= 8) {
            const size_t doff = (((size_t)b * 128 + (j - 8)) * 2 + kvh) * 64 + 4 * ch;
            __builtin_nontemporal_store(ca[u], (f32x4*)(out + O_WKS + doff)); __builtin_nontemporal_store(cc[u], (f32x4*)(out + O_WKS + doff + 32));
            __builtin_nontemporal_store(cv0[u], (f32x4*)(out + O_WVS + doff)); __builtin_nontemporal_store(cv1[u], (f32x4*)(out + O_WVS + doff + 32));
        }
    }
    if (tid < 256) { const int j = (tid + 1024) >> 3, ch = tid & 7; *(LAS u32x4*)(Kl + j * 80 + ch * 8) = kz; *(LAS u32x4*)(Vt + j * 80 + ch * 8) = vz; }
    __syncthreads();
    if (wave < 2) {
        MaskBand mk; mk.lo = t + 1; mk.hi = t + 128;
        f32x4 o[4];
        attn_rowblock<64, 10, true, MaskBand>(qf, Kl, 80, Vt, 80, 0, mk, sinks[head], o, fr, fq);
#pragma unroll
        for (int db = 0; db < 4; ++db) *(u32x2*)(BR + (size_t)qrow * NBR + head * 64 + 16 * db + 4 * fq) = pack4(o[db]);
    }
}
__device__ __forceinline__ void p2_mem_prompt(LAS unsigned char* lds, const bf16* Z, bf16* BR, const bf16* MK, const bf16* MVT, int item, int tid, int wave, int lane) {
    const int h = item >> 6, rblk = item & 63, fr = lane & 15, fq = lane >> 4;
    LAS bf16* Kl = (LAS bf16*)lds; LAS bf16* Vt = (LAS bf16*)(lds + 256 * 144 * 2);
    bf16x8 qfa[2][4];
#pragma unroll
    for (int q = 0; q < 2; ++q)
#pragma unroll
        for (int kc = 0; kc < 4; ++kc) qfa[q][kc] = *(const bf16x8*)(Z + (size_t)(rblk * 256 + (wave * 2 + q) * 16 + fr) * NZ + ZMQ + h * 128 + kc * 32 + 8 * fq);
    {
        u32x4 kreg[8], vreg[8];
#pragma unroll
        for (int u = 0; u < 8; ++u) { const int idx = tid + u * 512, m = idx >> 4, ch = idx & 15; kreg[u] = *(const u32x4*)(MK + (size_t)m * 512 + h * 128 + ch * 8); vreg[u] = *(const u32x4*)(MVT + (size_t)m * 512 + h * 128 + ch * 8); }
        __syncthreads();
#pragma unroll
        for (int u = 0; u < 8; ++u) { const int idx = tid + u * 512, m = idx >> 4, ch = idx & 15; *(LAS u32x4*)(Kl + m * 144 + ch * 8) = kreg[u]; *(LAS u32x4*)(Vt + m * 144 + ch * 8) = vreg[u]; }
    }
    __syncthreads();
#pragma unroll
    for (int q = 0; q < 2; ++q) {
        const int qrow = rblk * 256 + (wave * 2 + q) * 16 + fr;
        bf16x8 qf[4];
#pragma unroll
        for (int kc = 0; kc < 4; ++kc) qf[kc] = qfa[q][kc];
        f32x4 o[8];
        attn_rowblock<128, 16, false, MaskNone>(qf, Kl, 144, Vt, 144, 0, MaskNone(), 0.f, o, fr, fq);
#pragma unroll
        for (int db = 0; db < 8; ++db) *(u32x2*)(BR + (size_t)qrow * NBR + 1024 + h * 128 + 16 * db + 4 * fq) = pack4(o[db]);
    }
}
__device__ __forceinline__ void p2_mem_sample(LAS unsigned char* lds, const bf16* Z, bf16* BR, const float* cmk, const float* cmv, int item, int tid, int wave, int lane) {
    const int b = item >> 2, h = item & 3, fr = lane & 15, fq = lane >> 4;
    LAS bf16* Kl = (LAS bf16*)lds; LAS bf16* Vt = (LAS bf16*)(lds + 256 * 144 * 2);
    const int qrow = LP + b * 8 + (fr & 7);
    bf16x8 qf[4];
    if (wave == 0) {
#pragma unroll
        for (int kc = 0; kc < 4; ++kc) qf[kc] = *(const bf16x8*)(Z + (size_t)qrow * NZ + ZMQ + h * 128 + kc * 32 + 8 * fq);
    }
    f32x4 kk[4][2], vv[4][2];
#pragma unroll
    for (int u = 0; u < 4; ++u) {
        const int idx = tid + u * 512, m = idx >> 4, ch = idx & 15;
        const size_t so = (((size_t)b * 256 + m) * 4 + h) * 128 + ch * 4;
        kk[u][0] = __builtin_nontemporal_load((const f32x4*)(cmk + so)); kk[u][1] = __builtin_nontemporal_load((const f32x4*)(cmk + so + 64));
        vv[u][0] = __builtin_nontemporal_load((const f32x4*)(cmv + so)); vv[u][1] = __builtin_nontemporal_load((const f32x4*)(cmv + so + 64));
    }
    __syncthreads();
#pragma unroll 1
    for (int it0 = 0; it0 < 8; it0 += 4) {
#pragma unroll
        for (int u = 0; u < 4; ++u) {
            const int idx = tid + (it0 + u) * 512, m = idx >> 4, ch = idx & 15;
            *(LAS u32x2*)(Kl + m * 144 + ch * 4) = pack4(kk[u][0]); *(LAS u32x2*)(Kl + m * 144 + 64 + ch * 4) = pack4(kk[u][1]);
            *(LAS u32x2*)(Vt + m * 144 + ch * 4) = pack4(vv[u][0]); *(LAS u32x2*)(Vt + m * 144 + 64 + ch * 4) = pack4(vv[u][1]);
        }
        if (it0 == 0) {
#pragma unroll
            for (int u = 0; u < 4; ++u) {
                const int idx = tid + (4 + u) * 512, m = idx >> 4, ch = idx & 15;
                const size_t so = (((size_t)b * 256 + m) * 4 + h) * 128 + ch * 4;
                kk[u][0] = __builtin_nontemporal_load((const f32x4*)(cmk + so)); kk[u][1] = __builtin_nontemporal_load((const f32x4*)(cmk + so + 64));
                vv[u][0] = __builtin_nontemporal_load((const f32x4*)(cmv + so)); vv[u][1] = __builtin_nontemporal_load((const f32x4*)(cmv + so + 64));
            }
        }
    }
    __syncthreads();
    if (wave == 0) {
        f32x4 o[8];
        attn_rowblock<128, 16, false, MaskNone>(qf, Kl, 144, Vt, 144, 0, MaskNone(), 0.f, o, fr, fq);
        if (fr < 8) {
#pragma unroll
            for (int db = 0; db < 8; ++db) *(u32x2*)(BR + (size_t)qrow * NBR + 1024 + h * 128 + 16 * db + 4 * fq) = pack4(o[db]);
        }
    }
}
__device__ __forceinline__ void p2_sg_prompt(LAS unsigned char* lds, const bf16* Z, bf16* BR, const float* ln_g, const float* ln_b, const float* sg_w, const float* sg_b, int item, int tid, int wave, int lane) {
    const int chunk = item >> 1, g0 = (item & 1) * 2, fr = lane & 15, fq = lane >> 4;
    LAS float* st = (LAS float*)lds; LAS bf16* Wl = (LAS bf16*)(lds + 1024); LAS bf16* Vt = (LAS bf16*)(lds + 1024 + 128 * 144 * 2);
    const int tb = wave;
    u32x4 vraw[4]; f32x4 wa[4], wc_[4], uu0;
#define MK_SG_LOADS(g_) do { _Pragma("unroll") for (int u = 0; u < 4; ++u) { const int idx = tid + u * 512, t = idx >> 4, ch = idx & 15; \
        const float* src = sg_w + ((size_t)(g_) * 128 + t) * 128 + ch * 4; wa[u] = *(const f32x4*)src; wc_[u] = *(const f32x4*)(src + 64); \
        vraw[u] = *(const u32x4*)(Z + (size_t)(chunk * 128 + t) * NZ + ZSV + (g_) * 128 + ch * 8); } \
        uu0 = bf4(Z + (size_t)(chunk * 128 + 16 * tb + fr) * NZ + ZU + (g_) * 128 + 4 * fq); } while (0)
    {
        u32x4 raw[16];
#pragma unroll
        for (int rr = 0; rr < 16; ++rr) raw[rr] = *(const u32x4*)(Z + (size_t)(chunk * 128 + wave * 16 + rr) * NZ + ZSV + lane * 8);
        MK_SG_LOADS(g0);
        __syncthreads();
#pragma unroll
        for (int rr = 0; rr < 16; ++rr) {
            const int s = wave * 16 + rr;
            f32x4 a, c; unpack8(raw[rr], a, c);
            const float mean = wave_sum((a[0] + a[1]) + (a[2] + a[3]) + (c[0] + c[1]) + (c[2] + c[3])) * (1.f / 512.f);
            a = a - mean; c = c - mean;
            const float var = wave_sum((a[0] * a[0] + a[1] * a[1]) + (a[2] * a[2] + a[3] * a[3]) + (c[0] * c[0] + c[1] * c[1]) + (c[2] * c[2] + c[3] * c[3])) * (1.f / 512.f);
            if (lane == 0) { st[2 * s] = mean; st[2 * s + 1] = 1.0f / sqrtf(var + EPS); }
        }
    }
#pragma unroll 1
    for (int gi = 0; gi < 2; ++gi) {
        const int g = g0 + gi;
        __syncthreads();
        const f32x4 uu0c = uu0;
#pragma unroll
        for (int u = 0; u < 4; ++u) {
            const int idx = tid + u * 512, t = idx >> 4, ch = idx & 15;
            f32x4 a = wa[u], c = wc_[u];
#pragma unroll
            for (int e = 0; e < 4; ++e) { if (ch * 4 + e > t) a[e] = 0.f; if (64 + ch * 4 + e > t) c[e] = 0.f; }
            *(LAS u32x2*)(Wl + t * 144 + ch * 4) = pack4(a); *(LAS u32x2*)(Wl + t * 144 + 64 + ch * 4) = pack4(c);
            f32x4 va, vc; unpack8(vraw[u], va, vc);
            const float mean = st[2 * t], rstd = st[2 * t + 1];
            const f32x4 l0 = *(const f32x4*)(ln_g + g * 128 + ch * 8), l1 = *(const f32x4*)(ln_g + g * 128 + ch * 8 + 4);
            const f32x4 b0 = *(const f32x4*)(ln_b + g * 128 + ch * 8), b1 = *(const f32x4*)(ln_b + g * 128 + ch * 8 + 4);
            va = (va - mean) * rstd * l0 + b0; vc = (vc - mean) * rstd * l1 + b1;
            *(LAS u32x4*)(Vt + t * 144 + ch * 8) = pack8(va, vc);
        }
        if (gi == 0) MK_SG_LOADS(g0 + 1);
        __syncthreads();
        f32x4 acc[8];
#pragma unroll
        for (int cb = 0; cb < 8; ++cb) acc[cb] = (f32x4){0.f, 0.f, 0.f, 0.f};
#pragma unroll
        for (int kc = 0; kc < 4; ++kc) {
            if (32 * kc <= 16 * tb + 15) {
                const bf16x8 wf = *(const LAS bf16x8*)(Wl + (16 * tb + fr) * 144 + 32 * kc + 8 * fq);
#pragma unroll
                for (int cb = 0; cb < 8; ++cb) {
                    const LAS bf16* vp = Vt + (32 * kc + 8 * fq + (fr >> 2)) * 144 + 16 * cb + 4 * (fr & 3);
                    const s16x4 v0 = vtr(vp), v1 = vtr(vp + 4 * 144);
                    const bf16x8 vf = __builtin_shufflevector(v0, v1, 0, 1, 2, 3, 4, 5, 6, 7);
                    acc[cb] = __builtin_amdgcn_mfma_f32_16x16x32_bf16(vf, wf, acc[cb], 0, 0, 0);
                }
            }
        }
        const int t = 16 * tb + fr, row = chunk * 128 + t;
        const float bias = sg_b[g * 128 + t];
#pragma unroll
        for (int cb = 0; cb < 8; ++cb) {
            const int c = 16 * cb + 4 * fq;
            const f32x4 uu = cb == 0 ? uu0c : bf4(Z + (size_t)row * NZ + ZU + g * 128 + c);
            *(u32x2*)(BR + (size_t)row * NBR + 512 + g * 128 + c) = pack4(uu * (acc[cb] + bias));
        }
    }
}
__device__ __forceinline__ void p2_sg_sample(LAS unsigned char* lds, const bf16* Z, bf16* BR, const float* ln_g, const float* ln_b, const float* sg_w, const float* sg_b, float* out, int b, int tid, int wave, int lane) {
    LAS float* red = (LAS float*)lds;
    __syncthreads();
    const int c = tid, g = c >> 7;
    float x[8], vn[8];
#pragma unroll
    for (int t = 0; t < 8; ++t) x[t] = bf2f(Z[(size_t)(LP + b * 8 + t) * NZ + ZSV + c]);
#pragma unroll
    for (int t = 0; t < 8; ++t) { const float s1 = wave_sum(x[t]), s2 = wave_sum(x[t] * x[t]); if (lane == 0) { red[(wave * 8 + t) * 2] = s1; red[(wave * 8 + t) * 2 + 1] = s2; } }
    __syncthreads();
    const float lg = ln_g[c], lb = ln_b[c];
#pragma unroll
    for (int t = 0; t < 8; ++t) {
        float s1 = 0.f, s2 = 0.f;
#pragma unroll
        for (int w = 0; w < 8; ++w) { s1 += red[(w * 8 + t) * 2]; s2 += red[(w * 8 + t) * 2 + 1]; }
        const float mean = s1 * (1.f / 512.f), var = fmaxf(s2 * (1.f / 512.f) - mean * mean, 0.f);
        vn[t] = (x[t] - mean) * (1.0f / sqrtf(var + EPS)) * lg + lb;
        out[O_SGS + (size_t)(b * 8 + t) * 512 + c] = vn[t];
    }
#pragma unroll
    for (int t = 0; t < 8; ++t) {
        float m = sg_b[g * 128 + t];
#pragma unroll
        for (int s = 0; s <= t; ++s) m += sg_w[((size_t)g * 128 + t) * 128 + s] * vn[s];
        const size_t row = (size_t)(LP + b * 8 + t);
        BR[row * NBR + 512 + c] = f2bf(bf2f(Z[row * NZ + ZU + c]) * m);
    }
}

#define XB_TMO      128
#define XB_XCNT(j)  (256  + 64 * (j))
#define XB_XSUB(j)  (1280 + 64 * (j))
#define XB_XGEN(j)  (2304 + 64 * (j))
#define XB_TOP      3328
#define XB_TOPGEN   3392
#define XCD_BAR_WORDS 3456
#define XB_SPIN_CAP (1u << 18)

__device__ __forceinline__ unsigned xb_ld(unsigned* p)              { return __hip_atomic_load(p, __ATOMIC_RELAXED, __HIP_MEMORY_SCOPE_AGENT); }
__device__ __forceinline__ unsigned xb_add(unsigned* p, unsigned v) { return __hip_atomic_fetch_add(p, v, __ATOMIC_RELAXED, __HIP_MEMORY_SCOPE_AGENT); }
__device__ __forceinline__ unsigned xb_xcc_id() { return (unsigned)__builtin_amdgcn_s_getreg((3 << 11) | 20) & 0xFu; }
#define XB_SPIN(cond, bar) do { unsigned _sp = 0; while (cond) { __builtin_amdgcn_s_sleep(1); \
    if ((++_sp & 255u) == 0u) { if (xb_ld(&(bar)[XB_TMO])) break; if (_sp > XB_SPIN_CAP) { atomicAdd(&(bar)[XB_TMO], 1u); break; } } } } while (0)

struct XcdBarrier {
    unsigned* bar; unsigned x;
    volatile LAS unsigned* st;
};

__device__ __forceinline__ XcdBarrier xcd_barrier_post(unsigned* bar, volatile LAS unsigned* st) {
    XcdBarrier b; b.bar = bar; b.x = xb_xcc_id(); b.st = st;
    if (threadIdx.x == 0) (void)xb_add(&bar[XB_XCNT(b.x)], 1u);
    return b;
}
__device__ __forceinline__ void xcd_barrier_complete(unsigned* bar, unsigned x, unsigned& nloc, unsigned& nx) {
    const unsigned G = gridDim.x * gridDim.y * gridDim.z;
    unsigned sum, cnt, mine, sp = 0u;
    for (;;) {
        sum = 0u; cnt = 0u; mine = 0u;
#pragma unroll
        for (unsigned j = 0; j < 16; ++j) { const unsigned c = xb_ld(&bar[XB_XCNT(j)]); sum += c; cnt += (c > 0u) ? 1u : 0u; mine = (j == x) ? c : mine; }
        if (sum == G) break;
        __builtin_amdgcn_s_sleep(1);
        if ((++sp & 255u) == 0u) { if (xb_ld(&bar[XB_TMO])) break; if (sp > XB_SPIN_CAP) { atomicAdd(&bar[XB_TMO], 1u); break; } }
    }
    nloc = mine > 0u ? mine : 1u; nx = cnt > 0u ? cnt : 1u;
}

__device__ __forceinline__ void xcd_barrier(const XcdBarrier& b) {
    asm volatile("s_waitcnt vmcnt(0)" ::: "memory");
    __syncthreads();
    if (threadIdx.x == 0) {
        unsigned* bar = b.bar;
        __builtin_amdgcn_s_waitcnt(0);
        unsigned nloc = b.st[0], nx = b.st[1];
        if (nloc == 0u) { xcd_barrier_complete(bar, b.x, nloc, nx); b.st[0] = nloc; b.st[1] = nx; }
        const unsigned old = xb_add(&bar[XB_XSUB(b.x)], 1u);
        const unsigned gen = old / nloc;
        if (old + 1u == (gen + 1u) * nloc) {
            __builtin_amdgcn_fence(__ATOMIC_RELEASE, "agent");
            asm volatile("s_waitcnt vmcnt(0)" ::: "memory");
            const unsigned og = xb_add(&bar[XB_TOP], 1u);
            const unsigned tg = og / nx;
            if (og + 1u == (tg + 1u) * nx) xb_add(&bar[XB_TOPGEN], 1u);
            else XB_SPIN(xb_ld(&bar[XB_TOPGEN]) == tg, bar);
            __builtin_amdgcn_fence(__ATOMIC_ACQUIRE, "agent");
            xb_add(&bar[XB_XGEN(b.x)], 1u);
            asm volatile("s_waitcnt vmcnt(0)" ::: "memory");
        } else {
            XB_SPIN(xb_ld(&bar[XB_XGEN(b.x)]) == gen, bar);
            __builtin_amdgcn_fence(__ATOMIC_ACQUIRE, "agent");
            asm volatile("s_waitcnt vmcnt(0)" ::: "memory");
        }
    }
    __syncthreads();
}

struct Args { const float* in[25]; float* out; unsigned char* ws; int ph_lo, ph_hi, p2mask, nbar, dry, pad; };

__global__ void __launch_bounds__(512, 2) fwd_mega(Args args) {
    extern __shared__ __attribute__((aligned(16))) unsigned char lds_raw[];
    LAS unsigned char* lds = (LAS unsigned char*)lds_raw;
    const int tid = threadIdx.x, lane = tid & 63, wave = __builtin_amdgcn_readfirstlane(tid >> 6);
    const int G = gridDim.x, bid = blockIdx.x;
    const int gw = bid * 8 + wave, NGW = G * 8;
    const int gtid = bid * 512 + tid, NTHR = G * 512;
    const int lo = args.ph_lo, hi = args.ph_hi;
    unsigned char* ws = args.ws; float* out = args.out;
    const float* x_prompt = args.in[0]; const float* x_sample = args.in[1];
    bf16* WIN = (bf16*)(ws + W_WIN); bf16* WO = (bf16*)(ws + W_WO); bf16* WUP = (bf16*)(ws + W_WUP); bf16* WDN = (bf16*)(ws + W_WDN); bf16* WMKV = (bf16*)(ws + W_WMKV);
    float* ROPE = (float*)(ws + W_ROPE); bf16* MEMN = (bf16*)(ws + W_MEMN); bf16* MEMK = (bf16*)(ws + W_MEMK); bf16* MEMVT = (bf16*)(ws + W_MEMVT);
    bf16* XN = (bf16*)(ws + W_XN); bf16* Z = (bf16*)(ws + W_Z); bf16* ACT = Z;
    bf16* BR = (bf16*)out;
    bf16* FB = XN;
    bf16* PART = (bf16*)(ws + W_PART);
#define X1B_ROW(row) ((row) < X1B_SPLIT ? (bf16*)ws + (size_t)(row) * 1024 : (bf16*)(ws + W_X1B) + (size_t)((row) - X1B_SPLIT) * 1024)
#define IN_PH(k) (lo <= (k) && (k) < hi)
    volatile LAS unsigned* misc = (volatile LAS unsigned*)(lds + LDS_MISC);
    if (tid < 16) misc[tid] = 0u;
    __syncthreads();
    XcdBarrier bar = xcd_barrier_post((unsigned*)(ws + W_CTL), misc + 8);
#define SEAM(k) do { if (IN_PH(k) && IN_PH((k) + 1)) { for (int nb_ = 0; nb_ < args.nbar; ++nb_) xcd_barrier(bar); } } while (0)

    if (IN_PH(0)) {
        LAS float* scr = (LAS float*)(lds + wave * 16384);
        constexpr int I_IN = 16 * (NZ / 32), I_MKV = 16 * 32;
        for (int it = gw; it < I_IN + I_MKV; it += NGW) {
            if (it < I_IN) transpose_item(args.in[9], 1024, NZ, WIN, 0, true, scr, it, lane);
            else transpose_item(args.in[16], 1024, 1024, WMKV, 0, false, scr, it - I_IN, lane);
        }
        for (int m0 = gw; m0 < MT + 256; m0 += 2 * NGW) {
            const float* src[2]; const float* gn[2]; bf16* dst[2]; f32x4 v[2][4]; float s[2] = {0.f, 0.f};
            const int nr = m0 + NGW < MT + 256 ? 2 : 1;
#pragma unroll
            for (int q = 0; q < 2; ++q) {
                const int m = q < nr ? m0 + q * NGW : m0;
                if (m < LP) { src[q] = x_prompt + (size_t)m * 1024; gn[q] = args.in[8]; dst[q] = XN + (size_t)m * 1024; }
                else if (m < MT) { src[q] = x_sample + (size_t)(m - LP) * 1024; gn[q] = args.in[8]; dst[q] = XN + (size_t)m * 1024; }
                else { src[q] = args.in[7] + (size_t)(m - MT) * 1024; gn[q] = args.in[15]; dst[q] = MEMN + (size_t)(m - MT) * 1024; }
#pragma unroll
                for (int j = 0; j < 4; ++j) { v[q][j] = ((const f32x4*)src[q])[64 * j + lane]; s[q] += (v[q][j][0] * v[q][j][0] + v[q][j][1] * v[q][j][1]) + (v[q][j][2] * v[q][j][2] + v[q][j][3] * v[q][j][3]); }
            }
#pragma unroll
            for (int q = 0; q < 2; ++q) if (q < nr) {
                const float r = 1.0f / sqrtf(wave_sum(s[q]) * (1.f / 1024.f) + EPS);
#pragma unroll
                for (int j = 0; j < 4; ++j) { const f32x4 gv = ((const f32x4*)gn[q])[64 * j + lane]; *(u32x2*)(dst[q] + 4 * lane + 256 * j) = pack4(v[q][j] * r * gv); }
            }
        }
        for (int idx = gtid; idx < 16392 * 32; idx += NTHR) {
            const int pos = idx >> 5, i = idx & 31;
            double f = 0.15915494309189535;
            for (int k = 0; k < i; ++k) f *= 0.7498942093324559;
            double t = (double)pos * f; t -= floor(t);
            const float ft = (float)t;
            f32x2 cs_; cs_.x = __builtin_amdgcn_cosf(ft); cs_.y = __builtin_amdgcn_sinf(ft); *(f32x2*)(ROPE + 2 * idx) = cs_;
        }
    }
    SEAM(0);
    if (IN_PH(1)) {
        { Gemm g{XN, WIN, MT, NZ, 1024, 1024, 1024, 1 << 20, 1 << 20}; StaticOrder S; S.init(MT, NZ, G, bid); EpiZ E{Z, ROPE, out};
          gemm_phase<EpiZ, StaticOrder, true, true>(lds, g, S, E); }
        { Gemm g{MEMN, WMKV, 256, 1024, 1024, 1024, 1024, 1 << 20, 1 << 20}; RowListOrder S{bid - (G - 4), 4, 0}; EpiMemKV E{MEMK, MEMVT, out};
          gemm_phase<EpiMemKV, RowListOrder, true, true>(lds, g, S, E); }
        {
            int blo = ((MT / 256) * (NZ / 256)) % G, bhi = G - 4; if (bhi - blo < 16) { blo = 0; bhi = G; }
            if (bid >= blo && bid < bhi) {
                LAS float* scr = (LAS float*)(lds + wave * 16384);
                constexpr int I_O = 8 * 32;
                for (int it = (bid - blo) * 8 + wave; it < 3 * I_O; it += (bhi - blo) * 8) { const int n = it / I_O; transpose_item(args.in[17] + (size_t)n * 512 * 1024, 512, 1024, WO, n * 1024, false, scr, it % I_O, lane); }
            }
        }
    }
    SEAM(1);
    if (IN_PH(2)) {
        const float* sinks = args.in[10];
        const bool early = ((bid >> 3) & 1) != 0;
        const int pm_ = args.p2mask;
        if (early && (pm_ & 1)) for (int it = bid; it < 512; it += G) p2_mem_sample(lds, Z, BR, args.in[4], args.in[5], it, tid, wave, lane);
        if (pm_ & 2) for (int it = bid; it < 256; it += G) p2_swa_prompt(lds, Z, BR, sinks, it, tid, wave, lane);
        if (pm_ & 4) for (int it = bid; it < 256; it += G) p2_mem_prompt(lds, Z, BR, MEMK, MEMVT, it, tid, wave, lane);
        if (pm_ & 8) for (int it = bid; it < 256; it += G) p2_sg_prompt(lds, Z, BR, args.in[11], args.in[12], args.in[13], args.in[14], it, tid, wave, lane);
        if (!early && (pm_ & 1)) for (int it = bid; it < 512; it += G) p2_mem_sample(lds, Z, BR, args.in[4], args.in[5], it, tid, wave, lane);
        if (pm_ & 16) for (int it = G - 1 - bid; it < 256; it += G) p2_swa_sample(lds, Z, BR, sinks, args.in[2], args.in[3], out, it, tid, wave, lane);
        if (pm_ & 32) for (int it = bid; it < 128; it += G) p2_sg_sample(lds, Z, BR, args.in[11], args.in[12], args.in[13], args.in[14], out, it, tid, wave, lane);
        __syncthreads();
    }
    SEAM(2);
    if (IN_PH(3)) {
        { Gemm g{BR, WO, LP, 3072, 512, NBR, 512, 4, 1 << 20}; TripleOrder S; S.so.init(LP, 1024, G, bid); EpiGate3 E{Z};
          gemm_phase<EpiGate3, TripleOrder, true, true, true>(lds, g, S, E); }
        { Gemm g{BR, WO, MT, 3072, 512, NBR, 512, 4, 1 << 20}; SampleOrder S{bid}; EpiGate E{Z, args.dry};
          gemm_phase<EpiGate, SampleOrder, true, true>(lds, g, S, E); }
        {
            int blo = 48, bhi = G; if (bhi - blo < 16) blo = 0;
            if (bid >= blo) {
                LAS float* scr = (LAS float*)(lds + wave * 16384);
                constexpr int I_UP = 16 * (NUP / 32), I_DN = (DFF / 64) * 32;
                for (int it = (bid - blo) * 8 + wave; it < I_UP + I_DN; it += (bhi - blo) * 8) {
                    if (it < I_UP) transpose_item(args.in[20], 1024, NUP, WUP, 0, false, scr, it, lane);
                    else transpose_item(args.in[23], DFF, 1024, WDN, 0, false, scr, it - I_UP, lane);
                }
            }
        }
    }
    SEAM(3);
    if (IN_PH(4)) {
        const float* g1 = args.in[18]; const float* g2 = args.in[19];
        for (int rb = gw; rb < LP; rb += 8 * NGW) {
            u32x2 mr[8][4]; f32x4 xv[8][4];
#pragma unroll
            for (int q = 0; q < 8; ++q) {
                const int row = rb + q * NGW < LP ? rb + q * NGW : rb;
                const bf16* zr = Z + (size_t)row * NZ + ZG + 2048 + 4 * lane; const float* xr = x_prompt + (size_t)row * 1024 + 4 * lane;
#pragma unroll
                for (int j = 0; j < 4; ++j) { mr[q][j] = *(const u32x2*)(zr + 256 * j); xv[q][j] = *(const f32x4*)(xr + 256 * j); }
            }
#pragma unroll
            for (int q = 0; q < 8; ++q) if (rb + q * NGW < LP) {
                const int row = rb + q * NGW;
                f32x4 m[4]; float ss = 0.f;
#pragma unroll
                for (int j = 0; j < 4; ++j) { m[j] = (f32x4){bflo(mr[q][j].x), bfhi(mr[q][j].x), bflo(mr[q][j].y), bfhi(mr[q][j].y)}; ss += (m[j][0] * m[j][0] + m[j][1] * m[j][1]) + (m[j][2] * m[j][2] + m[j][3] * m[j][3]); }
                const float r1 = 1.0f / sqrtf(wave_sum(ss) * (1.f / 1024.f) + EPS);
                float s2 = 0.f;
#pragma unroll
                for (int j = 0; j < 4; ++j) {
                    const f32x4 gv = *(const f32x4*)(g1 + 4 * lane + 256 * j);
                    m[j] = xv[q][j] + m[j] * r1 * gv;
                    *(u32x2*)(X1B_ROW(row) + 4 * lane + 256 * j) = pack4(m[j]);
                    s2 += (m[j][0] * m[j][0] + m[j][1] * m[j][1]) + (m[j][2] * m[j][2] + m[j][3] * m[j][3]);
                }
                const float r2 = 1.0f / sqrtf(wave_sum(s2) * (1.f / 1024.f) + EPS);
#pragma unroll
                for (int j = 0; j < 4; ++j) { const f32x4 gv = *(const f32x4*)(g2 + 4 * lane + 256 * j); *(u32x2*)(XN + (size_t)row * 1024 + 4 * lane + 256 * j) = pack4(m[j] * r2 * gv); }
            }
        }
        for (int row = LP + gw; row < MT; row += NGW) {
            const bf16* zr = Z + (size_t)row * NZ + ZG + 4 * lane; const float* xr = x_sample + (size_t)(row - LP) * 1024 + 4 * lane;
            f32x4 m[4], xs[4]; float ss = 0.f;
#pragma unroll
            for (int j = 0; j < 4; ++j) { m[j] = bf4(zr + 2048 + 256 * j) + bf4(zr + 256 * j) + bf4(zr + 1024 + 256 * j); xs[j] = *(const f32x4*)(xr + 256 * j); ss += (m[j][0] * m[j][0] + m[j][1] * m[j][1]) + (m[j][2] * m[j][2] + m[j][3] * m[j][3]); }
            const float r1 = 1.0f / sqrtf(wave_sum(ss) * (1.f / 1024.f) + EPS);
            float s2 = 0.f;
#pragma unroll
            for (int j = 0; j < 4; ++j) {
                const f32x4 gv = *(const f32x4*)(g1 + 4 * lane + 256 * j);
                m[j] = xs[j] + m[j] * r1 * gv;
                *(u32x2*)(X1B_ROW(row) + 4 * lane + 256 * j) = pack4(m[j]);
                s2 += (m[j][0] * m[j][0] + m[j][1] * m[j][1]) + (m[j][2] * m[j][2] + m[j][3] * m[j][3]);
            }
            const float r2 = 1.0f / sqrtf(wave_sum(s2) * (1.f / 1024.f) + EPS);
#pragma unroll
            for (int j = 0; j < 4; ++j) { const f32x4 gv = *(const f32x4*)(g2 + 4 * lane + 256 * j); *(u32x2*)(XN + (size_t)row * 1024 + 4 * lane + 256 * j) = pack4(m[j] * r2 * gv); }
        }
    }
    SEAM(4);
    if (IN_PH(5)) {
        Gemm g{XN, WUP, 69 * 256, NUP, 1024, 1024, 1024, 1 << 20, 1 << 20, 1}; StaticOrder S; S.init(69 * 256, NUP, G, bid);
        EpiConv E{ACT, args.in[21], args.in[22], args.in[6], out, (LAS float*)(lds + 131072)};
        gemm_phase<EpiConv, StaticOrder, true, true>(lds, g, S, E);
    }
    SEAM(5);
    if (IN_PH(7)) {
        { Gemm g{ACT, WDN, LP, 1024, DFF, DFF, DFF, 1 << 20, 1 << 20}; StaticOrder S; S.init(LP, 1024, G, bid); EpiStore<false> E{FB, 1024, nullptr};
          gemm_phase<EpiStore<false>, StaticOrder, true, true>(lds, g, S, E); }
        { Gemm g{ACT, WDN, MT, 1024, 256, DFF, DFF, 4, 4}; SplitOrder S{bid, G}; EpiPart E{PART};
          gemm_phase<EpiPart, SplitOrder, true, true>(lds, g, S, E); }
    }
    SEAM(7);
    if (IN_PH(8)) {
        const float* g3 = args.in[24];
        for (int rb = gw; rb < LP; rb += 8 * NGW) {
            u32x2 fr_[8][4], xr_[8][4];
#pragma unroll
            for (int q = 0; q < 8; ++q) {
                const int row = rb + q * NGW < LP ? rb + q * NGW : rb;
#pragma unroll
                for (int j = 0; j < 4; ++j) { fr_[q][j] = *(const u32x2*)(FB + (size_t)row * 1024 + 4 * lane + 256 * j); xr_[q][j] = *(const u32x2*)(X1B_ROW(row) + 4 * lane + 256 * j); }
            }
#pragma unroll
            for (int q = 0; q < 8; ++q) if (rb + q * NGW < LP) {
                const int row = rb + q * NGW;
                f32x4 f[4]; float ss = 0.f;
#pragma unroll
                for (int j = 0; j < 4; ++j) { f[j] = (f32x4){bflo(fr_[q][j].x), bfhi(fr_[q][j].x), bflo(fr_[q][j].y), bfhi(fr_[q][j].y)}; ss += (f[j][0] * f[j][0] + f[j][1] * f[j][1]) + (f[j][2] * f[j][2] + f[j][3] * f[j][3]); }
                const float r = 1.0f / sqrtf(wave_sum(ss) * (1.f / 1024.f) + EPS);
#pragma unroll
                for (int j = 0; j < 4; ++j) {
                    const f32x4 gv = *(const f32x4*)(g3 + 4 * lane + 256 * j);
                    const f32x4 xo = (f32x4){bflo(xr_[q][j].x), bfhi(xr_[q][j].x), bflo(xr_[q][j].y), bfhi(xr_[q][j].y)};
                    const f32x4 yv = xo + f[j] * r * gv;
                    if (!args.dry) *(f32x4*)(out + (size_t)row * 1024 + 4 * lane + 256 * j) = yv;
                }
            }
        }
        for (int row = LP + gw; row < MT; row += NGW) {
            f32x4 f[4], xo[4]; float ss = 0.f;
#pragma unroll
            for (int j = 0; j < 4; ++j) {
                f[j] = (f32x4){0.f, 0.f, 0.f, 0.f};
#pragma unroll
                for (int ks = 0; ks < 11; ++ks) f[j] = f[j] + bf4(PART + ((size_t)ks * 1024 + (row - LP)) * 1024 + 4 * lane + 256 * j);
                xo[j] = bf4(X1B_ROW(row) + 4 * lane + 256 * j);
                ss += (f[j][0] * f[j][0] + f[j][1] * f[j][1]) + (f[j][2] * f[j][2] + f[j][3] * f[j][3]);
            }
            const float r = 1.0f / sqrtf(wave_sum(ss) * (1.f / 1024.f) + EPS);
#pragma unroll
            for (int j = 0; j < 4; ++j) {
                const f32x4 gv = *(const f32x4*)(g3 + 4 * lane + 256 * j);
                const f32x4 yv = xo[j] + f[j] * r * gv;
                if (!args.dry) *(f32x4*)(out + (size_t)row * 1024 + 4 * lane + 256 * j) = yv;
            }
        }
    }
#undef IN_PH
#undef SEAM
}
}

#ifndef MK_N_LAUNCHES
#define MK_N_LAUNCHES 1
#endif
extern "C" void kernel_launch(void* const* d_in, const int* in_sizes, int n_in, void* d_out, int out_size, void* d_ws, size_t ws_size, hipStream_t stream) {
    static int grid = 0;
    if (grid == 0) {
        if (n_in != 25 || out_size != (int)pg8::O_END || ws_size < pg8::W_END) { fprintf(stderr, "kernel_launch: unexpected shapes: n_in %d out %d ws %zu (need %zu)\n", n_in, out_size, ws_size, (size_t)pg8::W_END); grid = -1; return; }
        int dev = 0, cus = 0, per_cu = 0;
        if (hipGetDevice(&dev) != hipSuccess || hipDeviceGetAttribute(&cus, hipDeviceAttributeMultiprocessorCount, dev) != hipSuccess) { grid = -1; return; }
        if (hipFuncSetAttribute((const void*)pg8::fwd_mega, hipFuncAttributeMaxDynamicSharedMemorySize, pg8::LDS_BYTES) != hipSuccess) { fprintf(stderr, "kernel_launch: hipFuncSetAttribute failed\n"); grid = -1; return; }
        if (hipOccupancyMaxActiveBlocksPerMultiprocessor(&per_cu, (const void*)pg8::fwd_mega, 512, pg8::LDS_BYTES) != hipSuccess || per_cu < 1) { fprintf(stderr, "kernel_launch: occupancy query says %d blocks per CU\n", per_cu); per_cu = 1; }
        (void)hipGetLastError();
        grid = cus;
    }
    if (grid < 0) return;
    pg8::Args a{};
    for (int i = 0; i < 25; ++i) a.in[i] = (const float*)d_in[i];
    a.out = (float*)d_out; a.ws = (unsigned char*)d_ws; a.p2mask = 63; a.nbar = 1;
#if MK_N_LAUNCHES == 1
    a.ph_lo = 0; a.ph_hi = 9;
#ifdef MK_PROBE_NBAR
    a.nbar = MK_PROBE_NBAR;
#endif
    if (hipMemsetAsync((char*)d_ws + pg8::W_CTL, 0, pg8::CTL_BYTES, stream) != hipSuccess) { fprintf(stderr, "kernel_launch: memset failed\n"); return; }
    hipLaunchKernelGGL(pg8::fwd_mega, dim3(grid), dim3(512), pg8::LDS_BYTES, stream, a);
#else
    const int cuts[4] = {0, MK_PROBE_PHASE + 1, MK_PROBE_PHASE, MK_PROBE_PHASE + 1};
    for (int li = 0; li < 3; ++li) {
        a.ph_lo = li == 0 ? 0 : (li == 1 ? MK_PROBE_PHASE : MK_PROBE_PHASE + 1); a.ph_hi = li == 2 ? 9 : MK_PROBE_PHASE + 1; (void)cuts;
#ifdef MK_PROBE_DRY
        a.ph_lo = li == 0 ? 0 : MK_PROBE_PHASE; a.ph_hi = li == 0 ? MK_PROBE_PHASE : (li == 1 ? MK_PROBE_PHASE + 1 : 9); a.dry = li == 1 ? 1 : 0;
#endif
        if (a.ph_lo >= a.ph_hi) continue;
#ifdef MK_PROBE_P2MASK
        a.p2mask = li == 1 ? MK_PROBE_P2MASK : 63;
#endif
        (void)hipMemsetAsync((char*)d_ws + pg8::W_CTL, 0, pg8::CTL_BYTES, stream);
        hipLaunchKernelGGL(pg8::fwd_mega, dim3(grid), dim3(512), pg8::LDS_BYTES, stream, a);
    }
#endif
}
```

```cpp
#include <hip/hip_runtime.h>
#include <hip/hip_cooperative_groups.h>
#include <cstdio>
#include <cstdint>
#include <cmath>
namespace cg = cooperative_groups;

namespace pg8 {
#define PG8_LAS __attribute__((address_space(3)))
typedef unsigned short bf16_t;
typedef short bf16x8 __attribute__((ext_vector_type(8)));
typedef float f32x4 __attribute__((ext_vector_type(4)));
typedef unsigned u32x4 __attribute__((ext_vector_type(4)));
constexpr int BM = 256, BK = 64, HALF = 128, HTB = HALF * BK * 2  , STAGE_BYTES = 8 * HTB, NXCD = 8, WGM = 6;

__host__ __device__ __forceinline__ int lds_byte(int r, int c) { const int st = (r >> 4) * 2 + (c >> 5), rr = r & 15, cc = c & 31, ob = rr * 64 + cc * 2; return st * 1024 + (ob ^ (((ob >> 9) & 1) << 5)); }
__host__ __device__ __forceinline__ void stage_rc(int b, int& R, int& C) { const int st = b / 1024, sb = b % 1024, swz = sb ^ (((sb >> 9) & 1) << 5); R = (st >> 1) * 16 + swz / 64; C = (st & 1) * 32 + (swz % 64) / 2; }
__host__ __device__ __forceinline__ int perm32(int rho) { const int n = rho >> 4, i = rho & 15; return 8 * (i >> 2) + 4 * n + (i & 3); }

struct Unit { int pm, pn; };
struct Gemm { const bf16_t* A; const bf16_t* Bt; int M, N, K, lda, ldb, adiv, bmod, aperm; };
__device__ __forceinline__ int arow_of(const Gemm& g, int pm) { return g.aperm ? (pm < 65 ? 254 * pm - 2 : 16384 + 256 * (pm - 65)) : 256 * pm; }

struct StaticOrder {
    int nM, nN, nwg, G, c;
    __host__ __device__ void init(int M, int N, int G_, int c_) { nM = M / BM; nN = N / BM; nwg = nM * nN; G = G_; c = c_; }
    __host__ __device__ bool next(int i, Unit& u) const {
        const long L = (long)i * G + c; if (L >= nwg) return false;
        int wgid = (int)L; { const int q = nwg / NXCD, r = nwg % NXCD, xcd = wgid % NXCD, off = wgid / NXCD; wgid = (xcd < r ? xcd * (q + 1) : r * (q + 1) + (xcd - r) * q) + off; }
        const int nig = WGM * nN, gid = wgid / nig, fm = gid * WGM, gsz = (nM - fm) < WGM ? (nM - fm) : WGM;
        u.pm = fm + ((wgid % nig) % gsz); u.pn = (wgid % nig) / gsz; return true;
    }
    __device__ __forceinline__ void a_ready(const Unit&) const {}
    __device__ __forceinline__ void done(const Unit&) const {}
};
struct SplitOrder {
    int c, G;
    __device__ bool next(int i, Unit& u) const { if (i > 0 || c >= 176) return false; u.pm = 64 + c / 44; u.pn = c % 44; return true; }
    __device__ __forceinline__ void a_ready(const Unit&) const {}
    __device__ __forceinline__ void done(const Unit&) const {}
};
struct TripleOrder {
    StaticOrder so;
    __device__ bool next(int i, Unit& u) const { if (!so.next(i / 3, u)) return false; u.pn += 4 * (i % 3); return true; }
    __device__ __forceinline__ void a_ready(const Unit&) const {}
    __device__ __forceinline__ void done(const Unit&) const {}
};
struct SampleOrder {
    int c;
    __device__ bool next(int i, Unit& u) const { if (i > 0 || c >= 48) return false; u.pm = 64 + c / 12; u.pn = c % 12; return true; }
    __device__ __forceinline__ void a_ready(const Unit&) const {}
    __device__ __forceinline__ void done(const Unit&) const {}
};
struct RowListOrder {
    int c, cnt, pm0;
    __device__ bool next(int i, Unit& u) const { if (i > 0 || c < 0 || c >= cnt) return false; u.pm = pm0; u.pn = c; return true; }
    __device__ __forceinline__ void a_ready(const Unit&) const {}
    __device__ __forceinline__ void done(const Unit&) const {}
};

__device__ __forceinline__ unsigned cvt_pk_bf16(float lo, float hi) { unsigned r; asm volatile("v_cvt_pk_bf16_f32 %0, %1, %2" : "=v"(r) : "v"(lo), "v"(hi)); return r; }
typedef float f32x2 __attribute__((ext_vector_type(2)));
__device__ __forceinline__ f32x2 gelu_pk(f32x2 v) {
    const f32x2 av = __builtin_elementwise_abs(v), d = av * 0.2316418882f + 1.0f;
    f32x2 t; t.x = __builtin_amdgcn_rcpf(d.x); t.y = __builtin_amdgcn_rcpf(d.y);
    f32x2 q = t * 0.5307027145f + (-0.7265760135f); q = q * t + 0.7107068705f; q = q * t + (-0.142248368f); q = q * t + 0.127414796f; q = q * t;
    const f32x2 s = (v * v) * (-0.72134752044f);
    f32x2 e; e.x = __builtin_amdgcn_exp2f(s.x); e.y = __builtin_amdgcn_exp2f(s.y);
    const f32x2 m = v * (q * e), r = v - m;
    f32x2 o; o.x = v.x < 0.f ? m.x : r.x; o.y = v.y < 0.f ? m.y : r.y; return o;
}
__device__ __forceinline__ f32x4 gelu4(f32x4 v) { f32x2 a = gelu_pk((f32x2){v[0], v[1]}), b = gelu_pk((f32x2){v[2], v[3]}); return (f32x4){a.x, a.y, b.x, b.y}; }
__device__ __forceinline__ u32x4 pack8(f32x4 v0, f32x4 v1) { u32x4 w; w.x = cvt_pk_bf16(v0[0], v0[1]); w.y = cvt_pk_bf16(v0[2], v0[3]); w.z = cvt_pk_bf16(v1[0], v1[1]); w.w = cvt_pk_bf16(v1[2], v1[3]); return w; }

template <class Epi, class Sched, bool ALIGN_EPI = false, bool SP2 = false, bool CARRY = false>
__device__ __forceinline__ void gemm_phase(PG8_LAS unsigned char* lds, const Gemm g, const Sched& S, const Epi& E) {
    const int tid = threadIdx.x, wid = __builtin_amdgcn_readfirstlane(tid >> 6), lane = tid & 63, wr = wid >> 2, wc = wid & 3, fr = lane & 15, fq = lane >> 4;
    const int K = g.K, nt = K / BK;
    unsigned voffA[2], voffB[2];
#pragma unroll
    for (int i = 0; i < 2; ++i) { int R, C; stage_rc(tid * 16 + i * 8192, R, C); const int Rb = Epi::PERM ? ((R & ~31) + perm32(R & 31)) : R;
        const int Ra = g.aperm ? (8 * (16 * (R >> 6) + (R & 15)) + ((R >> 4) & 3)) : R; voffA[i] = (unsigned)(Ra * g.lda + C) * 2u; voffB[i] = (unsigned)(Rb * g.ldb + C) * 2u; }
    const size_t kstep = (size_t)(BK * 2);
    const size_t hstepA = (size_t)(g.aperm ? 4 : HALF) * g.lda * 2, hstepB = (size_t)HALF * g.ldb * 2;
    const size_t tstepB = 2 * hstepB;
    const unsigned ldsw = (unsigned)wid * 1024u;
    const int aoff = lds_byte(wr * 64 + fr, fq * 8), boff = lds_byte(wc * 32 + fr, fq * 8);
#define PG8_SA(b, h) (((b) * 2 + (h)) * HTB)
#define PG8_SB(b, h) ((4 + (b) * 2 + (h)) * HTB)
#define PG8_STAGE(bufoff, gbase, voff) do { _Pragma("unroll") for (int _i = 0; _i < 2; ++_i) \
        __builtin_amdgcn_global_load_lds((const unsigned*)((const char*)(gbase) + (voff)[_i]), (PG8_LAS unsigned*)(lds + (bufoff) + ldsw + _i * 8192), 16, 0, 0); } while (0)
#define PG8_LDA(dst, b, h) do { _Pragma("unroll") for (int m = 0; m < 4; ++m) _Pragma("unroll") for (int k = 0; k < 2; ++k) dst[m][k] = *(const PG8_LAS bf16x8*)(lds + PG8_SA(b, h) + aoff + m * 2048 + k * 1024); } while (0)
#define PG8_LDB(dst, b, h) do { _Pragma("unroll") for (int n = 0; n < 2; ++n) _Pragma("unroll") for (int k = 0; k < 2; ++k) dst[n][k] = *(const PG8_LAS bf16x8*)(lds + PG8_SB(b, h) + boff + n * 2048 + k * 1024); } while (0)
#define PG8_MMA(ai, bj, At, Bt) do { __builtin_amdgcn_s_setprio(1); _Pragma("unroll") for (int m = 0; m < 4; ++m) _Pragma("unroll") for (int n = 0; n < 2; ++n) _Pragma("unroll") for (int k = 0; k < 2; ++k) \
        acc[ai][bj][m][n] = __builtin_amdgcn_mfma_f32_16x16x32_bf16(Bt[n][k], At[m][k], acc[ai][bj][m][n], 0, 0, 0); __builtin_amdgcn_s_setprio(0); } while (0)
#define PG8_WAIT_V(n) asm volatile("s_waitcnt vmcnt(" #n ")" ::: "memory")
#define PG8_WAIT_L(n) asm volatile("s_waitcnt lgkmcnt(" #n ")" ::: "memory")
#define PG8_BAR __builtin_amdgcn_s_barrier()
#define PG8_SCHED __builtin_amdgcn_sched_barrier(0)
    Unit cur, nxt; int ui = 0;
    if (!S.next(0, cur)) return;
    f32x4 acc[2][2][4][2];
#pragma unroll
    for (int a = 0; a < 2; ++a)
#pragma unroll
        for (int b = 0; b < 2; ++b)
#pragma unroll
            for (int m = 0; m < 4; ++m)
#pragma unroll
                for (int n = 0; n < 2; ++n) acc[a][b][m][n] = (f32x4){0.f, 0.f, 0.f, 0.f};
    bf16x8 At[4][2], B0[2][2], B1[2][2];
    const char* cA = (const char*)g.A + (long)arow_of(g, cur.pm) * (long)(g.lda * 2) + (size_t)(cur.pn / g.adiv) * K * 2; const char* cB = (const char*)g.Bt + (size_t)(cur.pn % g.bmod) * tstepB + (size_t)(cur.pn / g.bmod) * K * 2;
    S.a_ready(cur);
    if constexpr (SP2) {
        PG8_STAGE(PG8_SB(0, 0), cB, voffB); PG8_STAGE(PG8_SB(0, 1), cB + hstepB, voffB); PG8_STAGE(PG8_SA(0, 0), cA, voffA); PG8_STAGE(PG8_SA(0, 1), cA + hstepA, voffA);
        if (wr == 1) PG8_BAR;
        PG8_WAIT_V(2); PG8_BAR;
        PG8_STAGE(PG8_SB(1, 0), cB + kstep, voffB); PG8_STAGE(PG8_SA(1, 0), cA + kstep, voffA); PG8_STAGE(PG8_SB(1, 1), cB + hstepB + kstep, voffB);
        PG8_WAIT_V(6); PG8_BAR;
    } else {
        PG8_STAGE(PG8_SB(0, 0), cB, voffB); PG8_STAGE(PG8_SA(0, 0), cA, voffA); PG8_STAGE(PG8_SB(0, 1), cB + hstepB, voffB); PG8_STAGE(PG8_SA(0, 1), cA + hstepA, voffA);
        if (wr == 1) PG8_BAR;
        PG8_WAIT_V(4); PG8_BAR;
        PG8_STAGE(PG8_SB(1, 0), cB + kstep, voffB); PG8_STAGE(PG8_SA(1, 0), cA + kstep, voffA); PG8_STAGE(PG8_SB(1, 1), cB + hstepB + kstep, voffB);
        PG8_WAIT_V(6); PG8_BAR;
    }
    for (;;) {
        const bool has_next = S.next(ui + 1, nxt);
        const char* nA = has_next ? (const char*)g.A + (long)arow_of(g, nxt.pm) * (long)(g.lda * 2) + (size_t)(nxt.pn / g.adiv) * K * 2 : cA; const char* nB = has_next ? (const char*)g.Bt + (size_t)(nxt.pn % g.bmod) * tstepB + (size_t)(nxt.pn / g.bmod) * K * 2 : cB;
        for (int t = 0; t < nt; t += 2) {
            const bool last = (t == nt - 2);
            const char* a1 = cA + (size_t)(t + 1) * kstep;
            const char* a2 = last ? nA : cA + (size_t)(t + 2) * kstep; const char* b2 = last ? nB : cB + (size_t)(t + 2) * kstep;
            const char* a3 = a2 + kstep; const char* b3 = b2 + kstep;
            if (last && has_next) S.a_ready(nxt);
            if constexpr (SP2) {
            PG8_LDB(B0, 0, 0); PG8_LDB(B1, 0, 1); PG8_SCHED; PG8_LDA(At, 0, 0); PG8_STAGE(PG8_SA(1, 1), a1 + hstepA, voffA);
            PG8_WAIT_V(8); PG8_WAIT_L(0); PG8_BAR; PG8_MMA(0, 0, At, B0); PG8_MMA(0, 1, At, B1); PG8_BAR; PG8_SCHED;
            PG8_LDA(At, 0, 1); PG8_STAGE(PG8_SB(0, 0), b2, voffB); PG8_STAGE(PG8_SB(0, 1), b2 + hstepB, voffB); PG8_STAGE(PG8_SA(0, 0), a2, voffA);
            PG8_WAIT_V(8); PG8_WAIT_L(0); PG8_BAR; PG8_MMA(1, 0, At, B0); PG8_MMA(1, 1, At, B1); PG8_BAR; PG8_SCHED;
            PG8_LDB(B0, 1, 0); PG8_LDB(B1, 1, 1); PG8_SCHED; PG8_LDA(At, 1, 0); PG8_STAGE(PG8_SA(0, 1), a2 + hstepA, voffA);
            PG8_WAIT_V(8); PG8_WAIT_L(0); PG8_BAR; PG8_MMA(0, 0, At, B0); PG8_MMA(0, 1, At, B1); PG8_BAR; PG8_SCHED;
            PG8_LDA(At, 1, 1); PG8_STAGE(PG8_SB(1, 0), b3, voffB); PG8_STAGE(PG8_SB(1, 1), b3 + hstepB, voffB); PG8_STAGE(PG8_SA(1, 0), a3, voffA);
            PG8_WAIT_V(8); PG8_WAIT_L(0); PG8_BAR; PG8_MMA(1, 0, At, B0); PG8_MMA(1, 1, At, B1); PG8_BAR; PG8_SCHED;
            } else {
            PG8_LDB(B0, 0, 0); PG8_SCHED; PG8_LDA(At, 0, 0); PG8_STAGE(PG8_SA(1, 1), a1 + hstepA, voffA);
            PG8_WAIT_L(8); PG8_BAR; PG8_WAIT_L(0); PG8_MMA(0, 0, At, B0); PG8_BAR; PG8_SCHED;
            PG8_LDB(B1, 0, 1); PG8_STAGE(PG8_SB(0, 0), b2, voffB);
            PG8_BAR; PG8_WAIT_L(0); PG8_MMA(0, 1, At, B1); PG8_BAR;
            PG8_LDA(At, 0, 1); PG8_STAGE(PG8_SA(0, 0), a2, voffA);
            PG8_BAR; PG8_WAIT_L(0); PG8_MMA(1, 0, At, B0); PG8_BAR; PG8_SCHED;
            PG8_STAGE(PG8_SB(0, 1), b2 + hstepB, voffB);
            PG8_WAIT_V(6); PG8_BAR; PG8_MMA(1, 1, At, B1); PG8_BAR;
            PG8_LDB(B0, 1, 0); PG8_SCHED; PG8_LDA(At, 1, 0); PG8_STAGE(PG8_SA(0, 1), a2 + hstepA, voffA);
            PG8_WAIT_L(8); PG8_BAR; PG8_WAIT_L(0); PG8_MMA(0, 0, At, B0); PG8_BAR; PG8_SCHED;
            PG8_LDB(B1, 1, 1); PG8_STAGE(PG8_SB(1, 0), b3, voffB);
            PG8_BAR; PG8_WAIT_L(0); PG8_MMA(0, 1, At, B1); PG8_BAR;
            PG8_LDA(At, 1, 1); PG8_STAGE(PG8_SA(1, 0), a3, voffA);
            PG8_BAR; PG8_WAIT_L(0); PG8_MMA(1, 0, At, B0); PG8_BAR; PG8_SCHED;
            PG8_STAGE(PG8_SB(1, 1), b3 + hstepB, voffB);
            PG8_WAIT_V(6); PG8_BAR; PG8_MMA(1, 1, At, B1); PG8_BAR;
            }
        }
        if constexpr (ALIGN_EPI) { if (wr == 0) PG8_BAR; }
        if constexpr (!Epi::AFTER_DRAIN) { E(acc, cur, wr, wc, fr, fq); S.done(cur); }
        if (!has_next) break;
        if (!(CARRY && cur.pn < 8))
#pragma unroll
        for (int a = 0; a < 2; ++a)
#pragma unroll
            for (int b = 0; b < 2; ++b)
#pragma unroll
                for (int m = 0; m < 4; ++m)
#pragma unroll
                    for (int n = 0; n < 2; ++n) acc[a][b][m][n] = (f32x4){0.f, 0.f, 0.f, 0.f};
        cur = nxt; cA = nA; cB = nB; ++ui;
        if constexpr (ALIGN_EPI) { if (wr == 1) PG8_BAR; }
    }
    PG8_WAIT_V(0);
    if constexpr (!ALIGN_EPI) { if (wr == 0) PG8_BAR; }
    PG8_BAR;
    if constexpr (Epi::AFTER_DRAIN) { E.fused(acc, cur, wr, wc, fr, fq, lds, wid, lane); S.done(cur); }
#undef PG8_SA
#undef PG8_SB
#undef PG8_STAGE
#undef PG8_LDA
#undef PG8_LDB
#undef PG8_MMA
#undef PG8_WAIT_V
#undef PG8_WAIT_L
#undef PG8_BAR
#undef PG8_SCHED
}

typedef unsigned short bf16;
typedef short s16x4 __attribute__((ext_vector_type(4)));
typedef unsigned u32x2 __attribute__((ext_vector_type(2)));
#define LAS PG8_LAS
constexpr int DMODEL = 1024, LP = 16384, MT = 17408, NZ = 5376, NBR = 1536, NUP = 5632, DFF = 2816;
constexpr int ZK = 512, ZV = 640, ZU = 768, ZSV = 1280, ZMQ = 1792, ZG = 2304;
constexpr float EPS = 1e-6f, LOG2E = 1.4426950408889634f;
constexpr size_t O_WKP = 17825792, O_WVP = O_WKP + 16384, O_MKP = O_WVP + 16384, O_MVP = O_MKP + 131072, O_CVP = O_MVP + 131072,
                 O_WKS = O_CVP + 11264, O_WVS = O_WKS + 2097152, O_SGS = O_WVS + 2097152, O_CVS = O_SGS + 524288, O_END = O_CVS + 1441792;
static_assert(O_END == 24292352, "output map");
constexpr size_t W_WIN = 0, W_WO = W_WIN + (size_t)NZ * 1024 * 2, W_WUP = W_WO + (size_t)3072 * 512 * 2, W_WDN = W_WUP + (size_t)NUP * 1024 * 2,
                 W_WMKV = W_WDN + (size_t)1024 * DFF * 2, W_ROPE = W_WMKV + (size_t)1024 * 1024 * 2, W_MEMN = W_ROPE + (size_t)16392 * 32 * 8,
                 W_MEMK = W_MEMN + (size_t)256 * 1024 * 2, W_MEMVT = W_MEMK + (size_t)256 * 512 * 2, W_HALO = W_MEMVT + (size_t)512 * 256 * 2,
                 W_XN = W_HALO + (size_t)272 * 2 * NUP * 2, W_Z = W_XN + (size_t)MT * 1024 * 2, W_PART = W_Z + (size_t)104857600, W_X1B = W_Z + (size_t)MT * NZ * 2, X1B_SPLIT = 5120, W_CTL = W_X1B + (size_t)(MT - X1B_SPLIT) * 2048, CTL_BYTES = 16384, W_END = W_CTL + CTL_BYTES;
static_assert((size_t)X1B_SPLIT * 2048 <= (size_t)NZ * 1024 * 2 && W_PART >= W_Z + (size_t)MT * DFF * 2 && W_PART + (size_t)11 * 1024 * 1024 * 2 <= W_X1B && W_X1B % 256 == 0 && W_CTL % 256 == 0, "ws map");
static_assert(W_Z % 256 == 0 && W_XN % 256 == 0 && W_HALO % 256 == 0, "ws alignment");
constexpr int LDS_BYTES = 163840, LDS_MISC = LDS_BYTES - 64;

__device__ __forceinline__ float bf2f(unsigned short b) { return __uint_as_float((unsigned)b << 16); }
__device__ __forceinline__ float bflo(unsigned w) { return __uint_as_float(w << 16); }
__device__ __forceinline__ float bfhi(unsigned w) { return __uint_as_float(w & 0xffff0000u); }
__device__ __forceinline__ unsigned short f2bf(float f) { unsigned u = __float_as_uint(f); return (unsigned short)((u + 0x7fffu + ((u >> 16) & 1u)) >> 16); }
__device__ __forceinline__ f32x4 bf4(const bf16* p) { const u32x2 w = *(const u32x2*)p; return (f32x4){bflo(w.x), bfhi(w.x), bflo(w.y), bfhi(w.y)}; }
__device__ __forceinline__ void unpack8(u32x4 w, f32x4& a, f32x4& b) { a = (f32x4){bflo(w.x), bfhi(w.x), bflo(w.y), bfhi(w.y)}; b = (f32x4){bflo(w.z), bfhi(w.z), bflo(w.w), bfhi(w.w)}; }
__device__ __forceinline__ u32x2 pack4(f32x4 v) { u32x2 w; w.x = cvt_pk_bf16(v[0], v[1]); w.y = cvt_pk_bf16(v[2], v[3]); return w; }
#define MK_DPPF(x, ctrl) __builtin_bit_cast(float, __builtin_amdgcn_update_dpp(0, __builtin_bit_cast(int, (x)), (ctrl), 0xf, 0xf, true))
__device__ __forceinline__ float wave_sum(float v) {
    v += MK_DPPF(v, 0xB1);
    v += MK_DPPF(v, 0x4E);
    v += MK_DPPF(v, 0x141);
    v += MK_DPPF(v, 0x140);
    const int iv = __builtin_bit_cast(int, v);
    const float r0 = __builtin_bit_cast(float, __builtin_amdgcn_readlane(iv, 0)), r1 = __builtin_bit_cast(float, __builtin_amdgcn_readlane(iv, 16));
    const float r2 = __builtin_bit_cast(float, __builtin_amdgcn_readlane(iv, 32)), r3 = __builtin_bit_cast(float, __builtin_amdgcn_readlane(iv, 48));
    return (r0 + r1) + (r2 + r3);
}
__device__ __forceinline__ float sigmoidf_(float x) { return __builtin_amdgcn_rcpf(1.f + __builtin_amdgcn_exp2f(-LOG2E * x)); }
__device__ __forceinline__ f32x4 sigmoid4(f32x4 v) { return (f32x4){sigmoidf_(v[0]), sigmoidf_(v[1]), sigmoidf_(v[2]), sigmoidf_(v[3])}; }
__device__ __forceinline__ float gelu_tanh(float x) { const float p = __builtin_fmaf(x * x, -0.10294324f, -2.3022082f); return x * __builtin_amdgcn_rcpf(1.f + __builtin_amdgcn_exp2f(x * p)); }

struct EpiZ {
    static constexpr bool PERM = true, AFTER_DRAIN = false;
    bf16* Z; const float* rope; float* out;
    __device__ __forceinline__ void operator()(const f32x4 (&acc)[2][2][4][2], const Unit& u, int wr, int wc, int fr, int fq) const {
        const int pn = u.pn;
#pragma unroll
        for (int ai = 0; ai < 2; ++ai)
#pragma unroll
            for (int m = 0; m < 4; ++m) {
                const int r = u.pm * BM + ai * HALF + wr * 64 + m * 16 + fr;
                bf16* zrow = Z + (size_t)r * NZ;
#pragma unroll
                for (int bj = 0; bj < 2; ++bj) {
                    const int c0 = pn * BM + bj * HALF + wc * 32 + 8 * fq;
                    f32x4 v0 = acc[ai][bj][m][0], v1 = acc[ai][bj][m][1];
                    if (pn < 2 || (pn == 2 && bj == 0)) {
                        const int pos = r < LP ? r : LP + ((r - LP) & 7);
                        const int i0 = (c0 & 63) >> 1;
                        const float* tp = rope + ((size_t)pos * 32 + i0) * 2;
                        const f32x4 t0 = *(const f32x4*)tp, t1 = *(const f32x4*)(tp + 4);
                        f32x4 o0, o1;
                        o0[0] = v0[0] * t0[0] - v0[1] * t0[1]; o0[1] = v0[1] * t0[0] + v0[0] * t0[1];
                        o0[2] = v0[2] * t0[2] - v0[3] * t0[3]; o0[3] = v0[3] * t0[2] + v0[2] * t0[3];
                        o1[0] = v1[0] * t1[0] - v1[1] * t1[1]; o1[1] = v1[1] * t1[0] + v1[0] * t1[1];
                        o1[2] = v1[2] * t1[2] - v1[3] * t1[3]; o1[3] = v1[3] * t1[2] + v1[2] * t1[3];
                        if (pn < 2) { o0 = o0 * 0.125f; o1 = o1 * 0.125f; }
                        else {
                            const int kvh = (c0 >> 6) & 1;
                            float* dst = nullptr;
                            if (r >= LP - 128 && r < LP) dst = out + O_WKP + (size_t)(r - (LP - 128)) * 128 + kvh * 64;
                            else if (r >= LP) dst = out + O_WKS + ((size_t)((r - LP) >> 3) * 128 + 120 + ((r - LP) & 7)) * 128 + kvh * 64;
                            if (dst) { *(f32x4*)(dst + i0) = (f32x4){o0[0], o0[2], o1[0], o1[2]}; *(f32x4*)(dst + 32 + i0) = (f32x4){o0[1], o0[3], o1[1], o1[3]}; }
                        }
                        v0 = o0; v1 = o1;
                    } else if (pn == 2) {
                        const int kvh = (c0 >> 6) & 1, d0 = c0 & 63;
                        float* dst = nullptr;
                        if (r >= LP - 128 && r < LP) dst = out + O_WVP + (size_t)(r - (LP - 128)) * 128 + kvh * 64;
                        else if (r >= LP) dst = out + O_WVS + ((size_t)((r - LP) >> 3) * 128 + 120 + ((r - LP) & 7)) * 128 + kvh * 64;
                        if (dst) { *(f32x4*)(dst + d0) = v0; *(f32x4*)(dst + d0 + 4) = v1; }
                    } else if (pn < 7) { v0 = gelu4(v0); v1 = gelu4(v1); }
                    else if (pn < 9) { v0 = v0 * 0.08838834764831845f; v1 = v1 * 0.08838834764831845f; }
                    else { v0 = sigmoid4(v0); v1 = sigmoid4(v1); }
                    *(u32x4*)(zrow + c0) = pack8(v0, v1);
                }
            }
    }
};
struct EpiMemKV {
    static constexpr bool PERM = true, AFTER_DRAIN = false;
    bf16* MK; bf16* MVT; float* out;
    __device__ __forceinline__ void operator()(const f32x4 (&acc)[2][2][4][2], const Unit& u, int wr, int wc, int fr, int fq) const {
#pragma unroll
        for (int ai = 0; ai < 2; ++ai)
#pragma unroll
            for (int m = 0; m < 4; ++m) {
                const int r = ai * HALF + wr * 64 + m * 16 + fr;
#pragma unroll
                for (int bj = 0; bj < 2; ++bj) {
                    const int c0 = u.pn * BM + bj * HALF + wc * 32 + 8 * fq;
                    const f32x4 v0 = acc[ai][bj][m][0], v1 = acc[ai][bj][m][1];
                    if (c0 < 512) {
                        float* dst = out + O_MKP + (size_t)r * 512 + c0; *(f32x4*)dst = v0; *(f32x4*)(dst + 4) = v1;
                        *(u32x4*)(MK + (size_t)r * 512 + c0) = pack8(v0, v1);
                    } else {
                        const int cv = c0 - 512;
                        float* dst = out + O_MVP + (size_t)r * 512 + cv; *(f32x4*)dst = v0; *(f32x4*)(dst + 4) = v1;
                        *(u32x4*)(MVT + (size_t)r * 512 + cv) = pack8(v0, v1);
                    }
                }
            }
    }
};
struct EpiGate {
    static constexpr bool PERM = true, AFTER_DRAIN = false;
    bf16* Z; int dry;
    __device__ __forceinline__ void operator()(const f32x4 (&acc)[2][2][4][2], const Unit& u, int wr, int wc, int fr, int fq) const {
        bf16* p0 = Z + (size_t)(u.pm * BM + wr * 64 + fr) * NZ + ZG + u.pn * BM + wc * 32 + 8 * fq;
        u32x4 gt[2][4][2];
#pragma unroll
        for (int ai = 0; ai < 2; ++ai)
#pragma unroll
            for (int m = 0; m < 4; ++m)
#pragma unroll
                for (int bj = 0; bj < 2; ++bj) gt[ai][m][bj] = *(const u32x4*)(p0 + (size_t)(ai * HALF + m * 16) * NZ + bj * HALF);
#pragma unroll
        for (int ai = 0; ai < 2; ++ai)
#pragma unroll
            for (int m = 0; m < 4; ++m)
#pragma unroll
                for (int bj = 0; bj < 2; ++bj) {
                    f32x4 g0, g1; unpack8(gt[ai][m][bj], g0, g1);
                    const u32x4 w = pack8(acc[ai][bj][m][0] * g0, acc[ai][bj][m][1] * g1);
                    if (!dry) *(u32x4*)(p0 + (size_t)(ai * HALF + m * 16) * NZ + bj * HALF) = w;
                }
    }
};
struct EpiGate3 {
    static constexpr bool PERM = true, AFTER_DRAIN = false;
    bf16* Z;
    __device__ __forceinline__ void operator()(f32x4 (&acc)[2][2][4][2], const Unit& u, int wr, int wc, int fr, int fq) const {
        const int n = u.pn >> 2, pnc = u.pn & 3;
        bf16* p0 = Z + (size_t)(u.pm * BM + wr * 64 + fr) * NZ + ZG + pnc * BM + wc * 32 + 8 * fq;
        if (n < 2) {
#pragma unroll
            for (int ai = 0; ai < 2; ++ai) {
                u32x4 ga[4][2], gb[4][2];
#pragma unroll
                for (int m = 0; m < 4; ++m)
#pragma unroll
                    for (int bj = 0; bj < 2; ++bj) { const bf16* p = p0 + (size_t)(ai * HALF + m * 16) * NZ + bj * HALF + n * 1024; ga[m][bj] = *(const u32x4*)p; gb[m][bj] = *(const u32x4*)(p + 1024); }
#pragma unroll
                for (int m = 0; m < 4; ++m)
#pragma unroll
                    for (int bj = 0; bj < 2; ++bj) {
                        f32x4 a0, a1, b0, b1; unpack8(ga[m][bj], a0, a1); unpack8(gb[m][bj], b0, b1);
#pragma unroll
                        for (int e = 0; e < 4; ++e) {
                            acc[ai][bj][m][0][e] *= fmaxf(a0[e], 1e-30f) * __builtin_amdgcn_rcpf(fmaxf(b0[e], 1e-30f));
                            acc[ai][bj][m][1][e] *= fmaxf(a1[e], 1e-30f) * __builtin_amdgcn_rcpf(fmaxf(b1[e], 1e-30f));
                        }
                    }
            }
        } else {
            u32x4 gt[2][4][2];
#pragma unroll
            for (int ai = 0; ai < 2; ++ai)
#pragma unroll
                for (int m = 0; m < 4; ++m)
#pragma unroll
                    for (int bj = 0; bj < 2; ++bj) gt[ai][m][bj] = *(const u32x4*)(p0 + (size_t)(ai * HALF + m * 16) * NZ + bj * HALF + 2048);
#pragma unroll
            for (int ai = 0; ai < 2; ++ai)
#pragma unroll
                for (int m = 0; m < 4; ++m)
#pragma unroll
                    for (int bj = 0; bj < 2; ++bj) {
                        f32x4 g0, g1; unpack8(gt[ai][m][bj], g0, g1);
#pragma unroll
                        for (int e = 0; e < 4; ++e) { g0[e] = fmaxf(g0[e], 1e-30f); g1[e] = fmaxf(g1[e], 1e-30f); }
                        *(u32x4*)(p0 + (size_t)(ai * HALF + m * 16) * NZ + bj * HALF + 2048) = pack8(acc[ai][bj][m][0] * g0, acc[ai][bj][m][1] * g1);
                    }
        }
    }
};
struct EpiPart {
    static constexpr bool PERM = true, AFTER_DRAIN = false;
    bf16* P;
    __device__ __forceinline__ void operator()(const f32x4 (&acc)[2][2][4][2], const Unit& u, int wr, int wc, int fr, int fq) const {
        const int ks = u.pn >> 2, ct = u.pn & 3;
#pragma unroll
        for (int ai = 0; ai < 2; ++ai)
#pragma unroll
            for (int m = 0; m < 4; ++m) {
                const int r = (u.pm - 64) * BM + ai * HALF + wr * 64 + m * 16 + fr;
#pragma unroll
                for (int bj = 0; bj < 2; ++bj) {
                    const int c0 = ct * BM + bj * HALF + wc * 32 + 8 * fq;
                    *(u32x4*)(P + ((size_t)ks * 1024 + r) * 1024 + c0) = pack8(acc[ai][bj][m][0], acc[ai][bj][m][1]);
                }
            }
    }
};
__device__ __forceinline__ f32x4 gelu_tanh4(f32x4 v) { return (f32x4){gelu_tanh(v[0]), gelu_tanh(v[1]), gelu_tanh(v[2]), gelu_tanh(v[3])}; }
__device__ __forceinline__ float MK_SHR1(float x) { const int xi = __builtin_bit_cast(int, x); return __builtin_bit_cast(float, __builtin_amdgcn_update_dpp(xi, xi, 0x111, 0xf, 0xf, false)); }
struct EpiConv {
    static constexpr bool PERM = true, AFTER_DRAIN = false;
    bf16* ACT; const float* cw; const float* cb; const float* sc; float* out; LAS float* xl;
    __device__ __forceinline__ void operator()(const f32x4 (&acc)[2][2][4][2], const Unit& u, int wr, int wc, int fr, int fq) const {
        const bool smp = u.pm >= 65;
        const int tau0 = 8 * (16 * wr + fr);
        const int t0 = smp ? LP + 256 * (u.pm - 65) + tau0 : 254 * u.pm - 2 + tau0;
        const int f0 = 128 * u.pn + 32 * wc + 8 * fq;
        f32x4 wg[3], wv[3], bg, bv;
#define MK_CONV_W(n_) do { _Pragma("unroll") for (int j3 = 0; j3 < 3; ++j3) { wg[j3] = *(const f32x4*)(cw + (size_t)j3 * NUP + f0 + 4 * (n_)); wv[j3] = *(const f32x4*)(cw + (size_t)j3 * NUP + DFF + f0 + 4 * (n_)); } \
        bg = *(const f32x4*)(cb + f0 + 4 * (n_)); bv = *(const f32x4*)(cb + DFF + f0 + 4 * (n_)); } while (0)
        MK_CONV_W(0);
        if (!smp) {
            if (wr == 0 && fr == 15) {
#pragma unroll
                for (int jj = 0; jj < 2; ++jj)
#pragma unroll
                    for (int bj = 0; bj < 2; ++bj)
#pragma unroll
                        for (int n = 0; n < 2; ++n) *(LAS f32x4*)(xl + ((((wc * 4 + fq) * 2 + jj) * 2 + bj) * 2 + n) * 4) = acc[1][bj][2 + jj][n];
            }
            asm volatile("s_waitcnt lgkmcnt(0)" ::: "memory"); __builtin_amdgcn_s_barrier(); asm volatile("" ::: "memory");
        }
        u32x2 keep[8];
#pragma unroll
        for (int n = 0; n < 2; ++n) {
            const int fc = f0 + 4 * n;
            if (n == 1) MK_CONV_W(1);
            f32x4 g2, g1, v2, v1;
            if (smp) {
                const float* p = sc + (size_t)((t0 - LP) >> 3) * 2 * NUP;
                g2 = *(const f32x4*)(p + fc); v2 = *(const f32x4*)(p + DFF + fc); g1 = *(const f32x4*)(p + NUP + fc); v1 = *(const f32x4*)(p + NUP + DFF + fc);
            } else {
#pragma unroll
                for (int e = 0; e < 4; ++e) {
                    g2[e] = MK_SHR1(acc[1][0][2][n][e]); g1[e] = MK_SHR1(acc[1][0][3][n][e]);
                    v2[e] = MK_SHR1(acc[1][1][2][n][e]); v1[e] = MK_SHR1(acc[1][1][3][n][e]);
                }
                if (fr == 0) {
                    if (wr == 1) {
                        const LAS float* xp = xl + (wc * 4 + fq) * 32 + n * 4;
                        g2 = *(const LAS f32x4*)(xp); v2 = *(const LAS f32x4*)(xp + 8); g1 = *(const LAS f32x4*)(xp + 16); v1 = *(const LAS f32x4*)(xp + 24);
                    } else { g2 = (f32x4){0.f, 0.f, 0.f, 0.f}; g1 = g2; v2 = g2; v1 = g2; }
                }
            }
#pragma unroll
            for (int j = 0; j < 8; ++j) {
                f32x4 ug = acc[j >> 2][0][j & 3][n], uv = acc[j >> 2][1][j & 3][n];
                if (!smp && u.pm == 0 && wr == 0 && fr == 0 && j < 2) { ug = (f32x4){0.f, 0.f, 0.f, 0.f}; uv = ug; }
                const f32x4 cgv = bg + wg[0] * g2 + wg[1] * g1 + wg[2] * ug;
                const f32x4 cvv = bv + wv[0] * v2 + wv[1] * v1 + wv[2] * uv;
                const f32x4 a = gelu_tanh4(cgv) * cvv;
                g2 = g1; g1 = ug; v2 = v1; v1 = uv;
                const int t = t0 + j;
                const bool ok = smp || (!(wr == 0 && fr == 0 && j < 2) && t < LP);
                const u32x2 pk = pack4(a);
                if (n == 0) keep[j] = pk;
                else if (ok) { u32x4 w; w.x = keep[j].x; w.y = keep[j].y; w.z = pk.x; w.w = pk.y; *(u32x4*)(ACT + (size_t)t * DFF + f0) = w; }
                if (smp) {
                    if (j >= 6) { float* dst = out + O_CVS + ((size_t)((t0 - LP) >> 3) * 2 + (j - 6)) * NUP; *(f32x4*)(dst + fc) = ug; *(f32x4*)(dst + DFF + fc) = uv; }
                } else if (t >= LP - 2 && t < LP) { float* dst = out + O_CVP + (size_t)(t - (LP - 2)) * NUP; *(f32x4*)(dst + fc) = ug; *(f32x4*)(dst + DFF + fc) = uv; }
            }
        }
    }
};
template <bool WITH_HALO> struct EpiStore {
    static constexpr bool PERM = true, AFTER_DRAIN = false;
    bf16* C; int ldc; bf16* halo;
    __device__ __forceinline__ void operator()(const f32x4 (&acc)[2][2][4][2], const Unit& u, int wr, int wc, int fr, int fq) const {
#pragma unroll
        for (int ai = 0; ai < 2; ++ai)
#pragma unroll
            for (int m = 0; m < 4; ++m) {
                const int r = u.pm * BM + ai * HALF + wr * 64 + m * 16 + fr;
#pragma unroll
                for (int bj = 0; bj < 2; ++bj) {
                    const int c0 = u.pn * BM + bj * HALF + wc * 32 + 8 * fq;
                    const u32x4 w = pack8(acc[ai][bj][m][0], acc[ai][bj][m][1]);
                    *(u32x4*)(C + (size_t)r * ldc + c0) = w;
                    if (WITH_HALO && m == 3 && fr >= 14 && r < LP) *(u32x4*)(halo + ((size_t)(r >> 6) * 2 + (r & 1)) * ldc + c0) = w;
                }
            }
    }
};

__device__ __forceinline__ void transpose_item(const float* W, int K, int N, bf16* WT, int row_off, bool qkperm, LAS float* scr, int item, int lane) {
    const int nblk = N / 32, kb = item / nblk, nb = item % nblk, k0 = 64 * kb, n0 = 32 * nb;
#pragma unroll 8
    for (int i = 0; i < 32; ++i) { const int kk = 2 * i + (lane >> 5); scr[kk * 33 + (lane & 31)] = W[(size_t)(k0 + kk) * N + n0 + (lane & 31)]; }
    asm volatile("s_waitcnt lgkmcnt(0)" ::: "memory");
    const int c = lane & 7;
#pragma unroll
    for (int j = 0; j < 4; ++j) {
        const int n = (lane >> 3) + 8 * j; const LAS float* s = scr + (8 * c) * 33 + n;
        u32x4 o; o.x = cvt_pk_bf16(s[0 * 33], s[1 * 33]); o.y = cvt_pk_bf16(s[2 * 33], s[3 * 33]); o.z = cvt_pk_bf16(s[4 * 33], s[5 * 33]); o.w = cvt_pk_bf16(s[6 * 33], s[7 * 33]);
        int ns = n0 + n; if (qkperm && ns < 640) ns = (ns & ~63) | ((ns & 31) << 1) | ((ns >> 5) & 1);
        if (N == NUP) { const int bj = ns >= DFF ? 1 : 0, f = ns - DFF * bj; ns = ((f >> 7) << 8) + (bj << 7) + (f & 127); }
        *(u32x4*)(WT + (size_t)(row_off + ns) * K + k0 + 8 * c) = o;
    }
    asm volatile("s_waitcnt lgkmcnt(0)" ::: "memory");
}
__device__ __forceinline__ void rms_row_to_bf16(const float* xrow, const float* g, bf16* orow, int lane) {
    const f32x4* xr = (const f32x4*)xrow + lane; f32x4 v[4]; float s = 0.f;
#pragma unroll
    for (int j = 0; j < 4; ++j) { v[j] = xr[64 * j]; s += (v[j][0] * v[j][0] + v[j][1] * v[j][1]) + (v[j][2] * v[j][2] + v[j][3] * v[j][3]); }
    const float r = 1.0f / sqrtf(wave_sum(s) * (1.f / 1024.f) + EPS);
#pragma unroll
    for (int j = 0; j < 4; ++j) { const f32x4 gv = ((const f32x4*)g)[64 * j + lane]; *(u32x2*)(orow + 4 * lane + 256 * j) = pack4(v[j] * r * gv); }
}

typedef short v4i16_t __attribute__((ext_vector_type(4)));
__device__ __forceinline__ s16x4 vtr(const LAS bf16* p) { return __builtin_bit_cast(s16x4, __builtin_amdgcn_ds_read_tr16_b64_v4i16((LAS v4i16_t*)p)); }
struct MaskBand { int lo, hi; __device__ __forceinline__ bool operator()(int key) const { return key >= lo && key <= hi; } };
struct MaskNone { __device__ __forceinline__ bool operator()(int) const { return true; } };

template <int D, int NKB, bool SINK, class Mask>
__device__ __forceinline__ void attn_rowblock(const bf16x8 (&qf)[D / 32], const LAS bf16* Kl, int ldk, const LAS bf16* Vt, int ldv, int key0, const Mask mask, float sink,
                                              f32x4 (&o)[D / 16], int fr, int fq) {
    f32x4 s[NKB];
#pragma unroll
    for (int cb = 0; cb < NKB; ++cb) {
        s[cb] = (f32x4){0.f, 0.f, 0.f, 0.f};
#pragma unroll
        for (int kc = 0; kc < D / 32; ++kc) {
            const bf16x8 kf = *(const LAS bf16x8*)(Kl + (key0 + 16 * cb + fr) * ldk + kc * 32 + 8 * fq);
            s[cb] = __builtin_amdgcn_mfma_f32_16x16x32_bf16(kf, qf[kc], s[cb], 0, 0, 0);
        }
    }
    float mx = -1e30f;
#pragma unroll
    for (int cb = 0; cb < NKB; ++cb)
#pragma unroll
        for (int e = 0; e < 4; ++e) { const bool ok = mask(key0 + 16 * cb + 4 * fq + e); const float v = ok ? s[cb][e] : -1e30f; s[cb][e] = v; mx = fmaxf(mx, v); }
    mx = fmaxf(mx, __shfl_xor(mx, 16)); mx = fmaxf(mx, __shfl_xor(mx, 32));
    if (SINK) mx = fmaxf(mx, sink);
    float l = 0.f;
#pragma unroll
    for (int cb = 0; cb < NKB; ++cb)
#pragma unroll
        for (int e = 0; e < 4; ++e) { const float p = __builtin_amdgcn_exp2f((s[cb][e] - mx) * LOG2E); s[cb][e] = p; l += p; }
    l += __shfl_xor(l, 16); l += __shfl_xor(l, 32);
    if (SINK) l += __builtin_amdgcn_exp2f((sink - mx) * LOG2E);
    const float inv = 1.0f / l;
#pragma unroll
    for (int db = 0; db < D / 16; ++db) o[db] = (f32x4){0.f, 0.f, 0.f, 0.f};
#pragma unroll
    for (int kc2 = 0; kc2 < NKB / 2; ++kc2) {
        const u32x4 pw = pack8(s[2 * kc2], s[2 * kc2 + 1]);
        const bf16x8 pf = __builtin_bit_cast(bf16x8, pw);
#pragma unroll
        for (int db = 0; db < D / 16; ++db) {
            const LAS bf16* vp = Vt + (key0 + 32 * kc2 + 4 * fq + (fr >> 2)) * ldv + 16 * db + 4 * (fr & 3);
            const s16x4 v0 = vtr(vp), v1 = vtr(vp + 16 * ldv);
            const bf16x8 vf = __builtin_shufflevector(v0, v1, 0, 1, 2, 3, 4, 5, 6, 7);
            o[db] = __builtin_amdgcn_mfma_f32_16x16x32_bf16(vf, pf, o[db], 0, 0, 0);
        }
    }
#pragma unroll
    for (int db = 0; db < D / 16; ++db) o[db] = o[db] * inv;
}

__device__ __forceinline__ void scatter8(LAS bf16* Vt, int ld, int d0, int j, u32x4 w) {
#pragma unroll
    for (int e = 0; e < 8; ++e) { const unsigned x = e < 2 ? w.x : e < 4 ? w.y : e < 6 ? w.z : w.w; Vt[(d0 + e) * ld + j] = (bf16)((e & 1) ? (x >> 16) : (x & 0xffffu)); }
}

__device__ __forceinline__ void p2_swa_prompt(LAS unsigned char* lds, const bf16* Z, bf16* BR, const float* sinks, int item, int tid, int wave, int lane) {
    const int blk = item >> 1, kvh = item & 1, fr = lane & 15, fq = lane >> 4;
    LAS bf16* Kl = (LAS bf16*)lds; LAS bf16* Vt = (LAS bf16*)(lds + 256 * 80 * 2);
    bf16x8 qfa[4][2];
#pragma unroll
    for (int q = 0; q < 4; ++q) {
        const int rb = wave * 4 + q, g = rb >> 3, ib = rb & 7;
#pragma unroll
        for (int kc = 0; kc < 2; ++kc) qfa[q][kc] = *(const bf16x8*)(Z + (size_t)(blk * 128 + ib * 16 + fr) * NZ + (kvh * 4 + g) * 64 + kc * 32 + 8 * fq);
    }
    {
        u32x4 kv[4], vv[4];
#pragma unroll
        for (int u = 0; u < 4; ++u) {
            const int idx = tid + u * 512, j = idx >> 3, ch = idx & 7, row = (blk - 1) * 128 + j;
            kv[u] = (u32x4){0u, 0u, 0u, 0u}; vv[u] = kv[u];
            if (row >= 0) { const bf16* zr = Z + (size_t)row * NZ + kvh * 64 + ch * 8; kv[u] = *(const u32x4*)(zr + ZK); vv[u] = *(const u32x4*)(zr + ZV); }
        }
        __syncthreads();
#pragma unroll
        for (int u = 0; u < 4; ++u) {
            const int idx = tid + u * 512, j = idx >> 3, ch = idx & 7;
            *(LAS u32x4*)(Kl + j * 80 + ch * 8) = kv[u];
            *(LAS u32x4*)(Vt + j * 80 + ch * 8) = vv[u];
        }
    }
    __syncthreads();
#pragma unroll
    for (int q = 0; q < 4; ++q) {
        const int rb = wave * 4 + q, g = rb >> 3, ib = rb & 7, head = kvh * 4 + g;
        const int qrow = blk * 128 + ib * 16 + fr;
        bf16x8 qf[2]; qf[0] = qfa[q][0]; qf[1] = qfa[q][1];
        const int key0 = 16 * (ib < 6 ? ib : 6), i = ib * 16 + fr;
        MaskBand mk; mk.lo = i + 1; mk.hi = i + 128; if (blk == 0 && mk.lo < 128) mk.lo = 128;
        f32x4 o[4];
        attn_rowblock<64, 10, true, MaskBand>(qf, Kl, 80, Vt, 80, key0, mk, sinks[head], o, fr, fq);
#pragma unroll
        for (int db = 0; db < 4; ++db) *(u32x2*)(BR + (size_t)qrow * NBR + head * 64 + 16 * db + 4 * fq) = pack4(o[db]);
    }
}
__device__ __forceinline__ void p2_swa_sample(LAS unsigned char* lds, const bf16* Z, bf16* BR, const float* sinks, const float* cwk, const float* cwv, float* out, int item, int tid, int wave, int lane) {
    const int b = item >> 1, kvh = item & 1, fr = lane & 15, fq = lane >> 4;
    LAS bf16* Kl = (LAS bf16*)lds; LAS bf16* Vt = (LAS bf16*)(lds + 256 * 80 * 2);
    const int g = wave * 2 + (fr >> 3), t = fr & 7, head = kvh * 4 + g, qrow = LP + b * 8 + t;
    bf16x8 qf[2];
    if (wave < 2) {
#pragma unroll
        for (int kc = 0; kc < 2; ++kc) qf[kc] = *(const bf16x8*)(Z + (size_t)qrow * NZ + head * 64 + kc * 32 + 8 * fq);
    }
    f32x4 ca[2], cc[2], cv0[2], cv1[2];
#pragma unroll
    for (int u = 0; u < 2; ++u) {
        const int idx = tid + u * 512, j = idx >> 3, ch = idx & 7;
        const size_t so = (((size_t)b * 128 + j) * 2 + kvh) * 64;
        const float* sk = cwk + so; const float* sv = cwv + so;
        ca[u] = __builtin_nontemporal_load((const f32x4*)(sk + 4 * ch)); cc[u] = __builtin_nontemporal_load((const f32x4*)(sk + 32 + 4 * ch));
        cv0[u] = __builtin_nontemporal_load((const f32x4*)(sv + 4 * ch)); cv1[u] = __builtin_nontemporal_load((const f32x4*)(sv + 32 + 4 * ch));
    }
    u32x4 kz = (u32x4){0u, 0u, 0u, 0u}, vz = kz;
    if (tid < 256 && ((tid + 1024) >> 3) < 136) {
        const int j = (tid + 1024) >> 3, ch = tid & 7;
        const bf16* zr = Z + (size_t)(LP + b * 8 + (j - 128)) * NZ + kvh * 64 + ch * 8; kz = *(const u32x4*)(zr + ZK); vz = *(const u32x4*)(zr + ZV);
    }
    __syncthreads();
#pragma unroll
    for (int u = 0; u < 2; ++u) {
        const int idx = tid + u * 512, j = idx >> 3, ch = idx & 7;
        u32x4 kv; kv.x = cvt_pk_bf16(ca[u][0], cc[u][0]); kv.y = cvt_pk_bf16(ca[u][1], cc[u][1]); kv.z = cvt_pk_bf16(ca[u][2], cc[u][2]); kv.w = cvt_pk_bf16(ca[u][3], cc[u][3]);
        *(LAS u32x4*)(Kl + j * 80 + ch * 8) = kv;
        *(LAS u32x2*)(Vt + j * 80 + ch * 4) = pack4(cv0[u]); *(LAS u32x2*)(Vt + j * 80 + 32 + ch * 4) = pack4(cv1[u]);
        if (j >= 8) {
            const size_t doff = (((size_t)b * 128 + (j - 8)) * 2 + kvh) * 64 + 4 * ch;
            __builtin_nontemporal_store(ca[u], (f32x4*)(out + O_WKS + doff)); __builtin_nontemporal_store(cc[u], (f32x4*)(out + O_WKS + doff + 32));
            __builtin_nontemporal_store(cv0[u], (f32x4*)(out + O_WVS + doff)); __builtin_nontemporal_store(cv1[u], (f32x4*)(out + O_WVS + doff + 32));
        }
    }
    if (tid < 256) { const int j = (tid + 1024) >> 3, ch = tid & 7; *(LAS u32x4*)(Kl + j * 80 + ch * 8) = kz; *(LAS u32x4*)(Vt + j * 80 + ch * 8) = vz; }
    __syncthreads();
    if (wave < 2) {
        MaskBand mk; mk.lo = t + 1; mk.hi = t + 128;
        f32x4 o[4];
        attn_rowblock<64, 10, true, MaskBand>(qf, Kl, 80, Vt, 80, 0, mk, sinks[head], o, fr, fq);
#pragma unroll
        for (int db = 0; db < 4; ++db) *(u32x2*)(BR + (size_t)qrow * NBR + head * 64 + 16 * db + 4 * fq) = pack4(o[db]);
    }
}
__device__ __forceinline__ void p2_mem_prompt(LAS unsigned char* lds, const bf16* Z, bf16* BR, const bf16* MK, const bf16* MVT, int item, int tid, int wave, int lane) {
    const int h = item >> 6, rblk = item & 63, fr = lane & 15, fq = lane >> 4;
    LAS bf16* Kl = (LAS bf16*)lds; LAS bf16* Vt = (LAS bf16*)(lds + 256 * 144 * 2);
    bf16x8 qfa[2][4];
#pragma unroll
    for (int q = 0; q < 2; ++q)
#pragma unroll
        for (int kc = 0; kc < 4; ++kc) qfa[q][kc] = *(const bf16x8*)(Z + (size_t)(rblk * 256 + (wave * 2 + q) * 16 + fr) * NZ + ZMQ + h * 128 + kc * 32 + 8 * fq);
    {
        u32x4 kreg[8], vreg[8];
#pragma unroll
        for (int u = 0; u < 8; ++u) { const int idx = tid + u * 512, m = idx >> 4, ch = idx & 15; kreg[u] = *(const u32x4*)(MK + (size_t)m * 512 + h * 128 + ch * 8); vreg[u] = *(const u32x4*)(MVT + (size_t)m * 512 + h * 128 + ch * 8); }
        __syncthreads();
#pragma unroll
        for (int u = 0; u < 8; ++u) { const int idx = tid + u * 512, m = idx >> 4, ch = idx & 15; *(LAS u32x4*)(Kl + m * 144 + ch * 8) = kreg[u]; *(LAS u32x4*)(Vt + m * 144 + ch * 8) = vreg[u]; }
    }
    __syncthreads();
#pragma unroll
    for (int q = 0; q < 2; ++q) {
        const int qrow = rblk * 256 + (wave * 2 + q) * 16 + fr;
        bf16x8 qf[4];
#pragma unroll
        for (int kc = 0; kc < 4; ++kc) qf[kc] = qfa[q][kc];
        f32x4 o[8];
        attn_rowblock<128, 16, false, MaskNone>(qf, Kl, 144, Vt, 144, 0, MaskNone(), 0.f, o, fr, fq);
#pragma unroll
        for (int db = 0; db < 8; ++db) *(u32x2*)(BR + (size_t)qrow * NBR + 1024 + h * 128 + 16 * db + 4 * fq) = pack4(o[db]);
    }
}
__device__ __forceinline__ void p2_mem_sample(LAS unsigned char* lds, const bf16* Z, bf16* BR, const float* cmk, const float* cmv, int item, int tid, int wave, int lane) {
    const int b = item >> 2, h = item & 3, fr = lane & 15, fq = lane >> 4;
    LAS bf16* Kl = (LAS bf16*)lds; LAS bf16* Vt = (LAS bf16*)(lds + 256 * 144 * 2);
    const int qrow = LP + b * 8 + (fr & 7);
    bf16x8 qf[4];
    if (wave == 0) {
#pragma unroll
        for (int kc = 0; kc < 4; ++kc) qf[kc] = *(const bf16x8*)(Z + (size_t)qrow * NZ + ZMQ + h * 128 + kc * 32 + 8 * fq);
    }
    f32x4 kk[4][2], vv[4][2];
#pragma unroll
    for (int u = 0; u < 4; ++u) {
        const int idx = tid + u * 512, m = idx >> 4, ch = idx & 15;
        const size_t so = (((size_t)b * 256 + m) * 4 + h) * 128 + ch * 4;
        kk[u][0] = __builtin_nontemporal_load((const f32x4*)(cmk + so)); kk[u][1] = __builtin_nontemporal_load((const f32x4*)(cmk + so + 64));
        vv[u][0] = __builtin_nontemporal_load((const f32x4*)(cmv + so)); vv[u][1] = __builtin_nontemporal_load((const f32x4*)(cmv + so + 64));
    }
    __syncthreads();
#pragma unroll 1
    for (int it0 = 0; it0 < 8; it0 += 4) {
#pragma unroll
        for (int u = 0; u < 4; ++u) {
            const int idx = tid + (it0 + u) * 512, m = idx >> 4, ch = idx & 15;
            *(LAS u32x2*)(Kl + m * 144 + ch * 4) = pack4(kk[u][0]); *(LAS u32x2*)(Kl + m * 144 + 64 + ch * 4) = pack4(kk[u][1]);
            *(LAS u32x2*)(Vt + m * 144 + ch * 4) = pack4(vv[u][0]); *(LAS u32x2*)(Vt + m * 144 + 64 + ch * 4) = pack4(vv[u][1]);
        }
        if (it0 == 0) {
#pragma unroll
            for (int u = 0; u < 4; ++u) {
                const int idx = tid + (4 + u) * 512, m = idx >> 4, ch = idx & 15;
                const size_t so = (((size_t)b * 256 + m) * 4 + h) * 128 + ch * 4;
                kk[u][0] = __builtin_nontemporal_load((const f32x4*)(cmk + so)); kk[u][1] = __builtin_nontemporal_load((const f32x4*)(cmk + so + 64));
                vv[u][0] = __builtin_nontemporal_load((const f32x4*)(cmv + so)); vv[u][1] = __builtin_nontemporal_load((const f32x4*)(cmv + so + 64));
            }
        }
    }
    __syncthreads();
    if (wave == 0) {
        f32x4 o[8];
        attn_rowblock<128, 16, false, MaskNone>(qf, Kl, 144, Vt, 144, 0, MaskNone(), 0.f, o, fr, fq);
        if (fr < 8) {
#pragma unroll
            for (int db = 0; db < 8; ++db) *(u32x2*)(BR + (size_t)qrow * NBR + 1024 + h * 128 + 16 * db + 4 * fq) = pack4(o[db]);
        }
    }
}
__device__ __forceinline__ void p2_sg_prompt(LAS unsigned char* lds, const bf16* Z, bf16* BR, const float* ln_g, const float* ln_b, const float* sg_w, const float* sg_b, int item, int tid, int wave, int lane) {
    const int chunk = item >> 1, g0 = (item & 1) * 2, fr = lane & 15, fq = lane >> 4;
    LAS float* st = (LAS float*)lds; LAS bf16* Wl = (LAS bf16*)(lds + 1024); LAS bf16* Vt = (LAS bf16*)(lds + 1024 + 128 * 144 * 2);
    const int tb = wave;
    u32x4 vraw[4]; f32x4 wa[4], wc_[4], uu0;
#define MK_SG_LOADS(g_) do { _Pragma("unroll") for (int u = 0; u < 4; ++u) { const int idx = tid + u * 512, t = idx >> 4, ch = idx & 15; \
        const float* src = sg_w + ((size_t)(g_) * 128 + t) * 128 + ch * 4; wa[u] = *(const f32x4*)src; wc_[u] = *(const f32x4*)(src + 64); \
        vraw[u] = *(const u32x4*)(Z + (size_t)(chunk * 128 + t) * NZ + ZSV + (g_) * 128 + ch * 8); } \
        uu0 = bf4(Z + (size_t)(chunk * 128 + 16 * tb + fr) * NZ + ZU + (g_) * 128 + 4 * fq); } while (0)
    {
        u32x4 raw[16];
#pragma unroll
        for (int rr = 0; rr < 16; ++rr) raw[rr] = *(const u32x4*)(Z + (size_t)(chunk * 128 + wave * 16 + rr) * NZ + ZSV + lane * 8);
        MK_SG_LOADS(g0);
        __syncthreads();
#pragma unroll
        for (int rr = 0; rr < 16; ++rr) {
            const int s = wave * 16 + rr;
            f32x4 a, c; unpack8(raw[rr], a, c);
            const float mean = wave_sum((a[0] + a[1]) + (a[2] + a[3]) + (c[0] + c[1]) + (c[2] + c[3])) * (1.f / 512.f);
            a = a - mean; c = c - mean;
            const float var = wave_sum((a[0] * a[0] + a[1] * a[1]) + (a[2] * a[2] + a[3] * a[3]) + (c[0] * c[0] + c[1] * c[1]) + (c[2] * c[2] + c[3] * c[3])) * (1.f / 512.f);
            if (lane == 0) { st[2 * s] = mean; st[2 * s + 1] = 1.0f / sqrtf(var + EPS); }
        }
    }
#pragma unroll 1
    for (int gi = 0; gi < 2; ++gi) {
        const int g = g0 + gi;
        __syncthreads();
        const f32x4 uu0c = uu0;
#pragma unroll
        for (int u = 0; u < 4; ++u) {
            const int idx = tid + u * 512, t = idx >> 4, ch = idx & 15;
            f32x4 a = wa[u], c = wc_[u];
#pragma unroll
            for (int e = 0; e < 4; ++e) { if (ch * 4 + e > t) a[e] = 0.f; if (64 + ch * 4 + e > t) c[e] = 0.f; }
            *(LAS u32x2*)(Wl + t * 144 + ch * 4) = pack4(a); *(LAS u32x2*)(Wl + t * 144 + 64 + ch * 4) = pack4(c);
            f32x4 va, vc; unpack8(vraw[u], va, vc);
            const float mean = st[2 * t], rstd = st[2 * t + 1];
            const f32x4 l0 = *(const f32x4*)(ln_g + g * 128 + ch * 8), l1 = *(const f32x4*)(ln_g + g * 128 + ch * 8 + 4);
            const f32x4 b0 = *(const f32x4*)(ln_b + g * 128 + ch * 8), b1 = *(const f32x4*)(ln_b + g * 128 + ch * 8 + 4);
            va = (va - mean) * rstd * l0 + b0; vc = (vc - mean) * rstd * l1 + b1;
            *(LAS u32x4*)(Vt + t * 144 + ch * 8) = pack8(va, vc);
        }
        if (gi == 0) MK_SG_LOADS(g0 + 1);
        __syncthreads();
        f32x4 acc[8];
#pragma unroll
        for (int cb = 0; cb < 8; ++cb) acc[cb] = (f32x4){0.f, 0.f, 0.f, 0.f};
#pragma unroll
        for (int kc = 0; kc < 4; ++kc) {
            if (32 * kc <= 16 * tb + 15) {
                const bf16x8 wf = *(const LAS bf16x8*)(Wl + (16 * tb + fr) * 144 + 32 * kc + 8 * fq);
#pragma unroll
                for (int cb = 0; cb < 8; ++cb) {
                    const LAS bf16* vp = Vt + (32 * kc + 8 * fq + (fr >> 2)) * 144 + 16 * cb + 4 * (fr & 3);
                    const s16x4 v0 = vtr(vp), v1 = vtr(vp + 4 * 144);
                    const bf16x8 vf = __builtin_shufflevector(v0, v1, 0, 1, 2, 3, 4, 5, 6, 7);
                    acc[cb] = __builtin_amdgcn_mfma_f32_16x16x32_bf16(vf, wf, acc[cb], 0, 0, 0);
                }
            }
        }
        const int t = 16 * tb + fr, row = chunk * 128 + t;
        const float bias = sg_b[g * 128 + t];
#pragma unroll
        for (int cb = 0; cb < 8; ++cb) {
            const int c = 16 * cb + 4 * fq;
            const f32x4 uu = cb == 0 ? uu0c : bf4(Z + (size_t)row * NZ + ZU + g * 128 + c);
            *(u32x2*)(BR + (size_t)row * NBR + 512 + g * 128 + c) = pack4(uu * (acc[cb] + bias));
        }
    }
}
__device__ __forceinline__ void p2_sg_sample(LAS unsigned char* lds, const bf16* Z, bf16* BR, const float* ln_g, const float* ln_b, const float* sg_w, const float* sg_b, float* out, int b, int tid, int wave, int lane) {
    LAS float* red = (LAS float*)lds;
    __syncthreads();
    const int c = tid, g = c >> 7;
    float x[8], vn[8];
#pragma unroll
    for (int t = 0; t < 8; ++t) x[t] = bf2f(Z[(size_t)(LP + b * 8 + t) * NZ + ZSV + c]);
#pragma unroll
    for (int t = 0; t < 8; ++t) { const float s1 = wave_sum(x[t]), s2 = wave_sum(x[t] * x[t]); if (lane == 0) { red[(wave * 8 + t) * 2] = s1; red[(wave * 8 + t) * 2 + 1] = s2; } }
    __syncthreads();
    const float lg = ln_g[c], lb = ln_b[c];
#pragma unroll
    for (int t = 0; t < 8; ++t) {
        float s1 = 0.f, s2 = 0.f;
#pragma unroll
        for (int w = 0; w < 8; ++w) { s1 += red[(w * 8 + t) * 2]; s2 += red[(w * 8 + t) * 2 + 1]; }
        const float mean = s1 * (1.f / 512.f), var = fmaxf(s2 * (1.f / 512.f) - mean * mean, 0.f);
        vn[t] = (x[t] - mean) * (1.0f / sqrtf(var + EPS)) * lg + lb;
        out[O_SGS + (size_t)(b * 8 + t) * 512 + c] = vn[t];
    }
#pragma unroll
    for (int t = 0; t < 8; ++t) {
        float m = sg_b[g * 128 + t];
#pragma unroll
        for (int s = 0; s <= t; ++s) m += sg_w[((size_t)g * 128 + t) * 128 + s] * vn[s];
        const size_t row = (size_t)(LP + b * 8 + t);
        BR[row * NBR + 512 + c] = f2bf(bf2f(Z[row * NZ + ZU + c]) * m);
    }
}

#define XB_TMO      128
#define XB_XCNT(j)  (256  + 64 * (j))
#define XB_XSUB(j)  (1280 + 64 * (j))
#define XB_XGEN(j)  (2304 + 64 * (j))
#define XB_TOP      3328
#define XB_TOPGEN   3392
#define XCD_BAR_WORDS 3456
#define XB_SPIN_CAP (1u << 18)

__device__ __forceinline__ unsigned xb_ld(unsigned* p)              { return __hip_atomic_load(p, __ATOMIC_RELAXED, __HIP_MEMORY_SCOPE_AGENT); }
__device__ __forceinline__ unsigned xb_add(unsigned* p, unsigned v) { return __hip_atomic_fetch_add(p, v, __ATOMIC_RELAXED, __HIP_MEMORY_SCOPE_AGENT); }
__device__ __forceinline__ unsigned xb_xcc_id() { return (unsigned)__builtin_amdgcn_s_getreg((3 << 11) | 20) & 0xFu; }
#define XB_SPIN(cond, bar) do { unsigned _sp = 0; while (cond) { __builtin_amdgcn_s_sleep(1); \
    if ((++_sp & 255u) == 0u) { if (xb_ld(&(bar)[XB_TMO])) break; if (_sp > XB_SPIN_CAP) { atomicAdd(&(bar)[XB_TMO], 1u); break; } } } } while (0)

struct XcdBarrier {
    unsigned* bar; unsigned x;
    volatile LAS unsigned* st;
};

__device__ __forceinline__ XcdBarrier xcd_barrier_post(unsigned* bar, volatile LAS unsigned* st) {
    XcdBarrier b; b.bar = bar; b.x = xb_xcc_id(); b.st = st;
    if (threadIdx.x == 0) (void)xb_add(&bar[XB_XCNT(b.x)], 1u);
    return b;
}
__device__ __forceinline__ void xcd_barrier_complete(unsigned* bar, unsigned x, unsigned& nloc, unsigned& nx) {
    const unsigned G = gridDim.x * gridDim.y * gridDim.z;
    unsigned sum, cnt, mine, sp = 0u;
    for (;;) {
        sum = 0u; cnt = 0u; mine = 0u;
#pragma unroll
        for (unsigned j = 0; j < 16; ++j) { const unsigned c = xb_ld(&bar[XB_XCNT(j)]); sum += c; cnt += (c > 0u) ? 1u : 0u; mine = (j == x) ? c : mine; }
        if (sum == G) break;
        __builtin_amdgcn_s_sleep(1);
        if ((++sp & 255u) == 0u) { if (xb_ld(&bar[XB_TMO])) break; if (sp > XB_SPIN_CAP) { atomicAdd(&bar[XB_TMO], 1u); break; } }
    }
    nloc = mine > 0u ? mine : 1u; nx = cnt > 0u ? cnt : 1u;
}

__device__ __forceinline__ void xcd_barrier(const XcdBarrier& b) {
    asm volatile("s_waitcnt vmcnt(0)" ::: "memory");
    __syncthreads();
    if (threadIdx.x == 0) {
        unsigned* bar = b.bar;
        __builtin_amdgcn_s_waitcnt(0);
        unsigned nloc = b.st[0], nx = b.st[1];
        if (nloc == 0u) { xcd_barrier_complete(bar, b.x, nloc, nx); b.st[0] = nloc; b.st[1] = nx; }
        const unsigned old = xb_add(&bar[XB_XSUB(b.x)], 1u);
        const unsigned gen = old / nloc;
        if (old + 1u == (gen + 1u) * nloc) {
            __builtin_amdgcn_fence(__ATOMIC_RELEASE, "agent");
            asm volatile("s_waitcnt vmcnt(0)" ::: "memory");
            const unsigned og = xb_add(&bar[XB_TOP], 1u);
            const unsigned tg = og / nx;
            if (og + 1u == (tg + 1u) * nx) xb_add(&bar[XB_TOPGEN], 1u);
            else XB_SPIN(xb_ld(&bar[XB_TOPGEN]) == tg, bar);
            __builtin_amdgcn_fence(__ATOMIC_ACQUIRE, "agent");
            xb_add(&bar[XB_XGEN(b.x)], 1u);
            asm volatile("s_waitcnt vmcnt(0)" ::: "memory");
        } else {
            XB_SPIN(xb_ld(&bar[XB_XGEN(b.x)]) == gen, bar);
            __builtin_amdgcn_fence(__ATOMIC_ACQUIRE, "agent");
            asm volatile("s_waitcnt vmcnt(0)" ::: "memory");
        }
    }
    __syncthreads();
}

struct Args { const float* in[25]; float* out; unsigned char* ws; int ph_lo, ph_hi, p2mask, nbar, dry, pad; };

__global__ void __launch_bounds__(512, 2) fwd_mega(Args args) {
    extern __shared__ __attribute__((aligned(16))) unsigned char lds_raw[];
    LAS unsigned char* lds = (LAS unsigned char*)lds_raw;
    const int tid = threadIdx.x, lane = tid & 63, wave = __builtin_amdgcn_readfirstlane(tid >> 6);
    const int G = gridDim.x, bid = blockIdx.x;
    const int gw = bid * 8 + wave, NGW = G * 8;
    const int gtid = bid * 512 + tid, NTHR = G * 512;
    const int lo = args.ph_lo, hi = args.ph_hi;
    unsigned char* ws = args.ws; float* out = args.out;
    const float* x_prompt = args.in[0]; const float* x_sample = args.in[1];
    bf16* WIN = (bf16*)(ws + W_WIN); bf16* WO = (bf16*)(ws + W_WO); bf16* WUP = (bf16*)(ws + W_WUP); bf16* WDN = (bf16*)(ws + W_WDN); bf16* WMKV = (bf16*)(ws + W_WMKV);
    float* ROPE = (float*)(ws + W_ROPE); bf16* MEMN = (bf16*)(ws + W_MEMN); bf16* MEMK = (bf16*)(ws + W_MEMK); bf16* MEMVT = (bf16*)(ws + W_MEMVT);
    bf16* XN = (bf16*)(ws + W_XN); bf16* Z = (bf16*)(ws + W_Z); bf16* ACT = Z;
    bf16* BR = (bf16*)out;
    bf16* FB = XN;
    bf16* PART = (bf16*)(ws + W_PART);
#define X1B_ROW(row) ((row) < X1B_SPLIT ? (bf16*)ws + (size_t)(row) * 1024 : (bf16*)(ws + W_X1B) + (size_t)((row) - X1B_SPLIT) * 1024)
#define IN_PH(k) (lo <= (k) && (k) < hi)
    volatile LAS unsigned* misc = (volatile LAS unsigned*)(lds + LDS_MISC);
    if (tid < 16) misc[tid] = 0u;
    __syncthreads();
    XcdBarrier bar = xcd_barrier_post((unsigned*)(ws + W_CTL), misc + 8);
#define SEAM(k) do { if (IN_PH(k) && IN_PH((k) + 1)) { for (int nb_ = 0; nb_ < args.nbar; ++nb_) xcd_barrier(bar); } } while (0)

    if (IN_PH(0)) {
        LAS float* scr = (LAS float*)(lds + wave * 16384);
        constexpr int I_IN = 16 * (NZ / 32), I_MKV = 16 * 32;
        for (int it = gw; it < I_IN + I_MKV; it += NGW) {
            if (it < I_IN) transpose_item(args.in[9], 1024, NZ, WIN, 0, true, scr, it, lane);
            else transpose_item(args.in[16], 1024, 1024, WMKV, 0, false, scr, it - I_IN, lane);
        }
        for (int m0 = gw; m0 < MT + 256; m0 += 2 * NGW) {
            const float* src[2]; const float* gn[2]; bf16* dst[2]; f32x4 v[2][4]; float s[2] = {0.f, 0.f};
            const int nr = m0 + NGW < MT + 256 ? 2 : 1;
#pragma unroll
            for (int q = 0; q < 2; ++q) {
                const int m = q < nr ? m0 + q * NGW : m0;
                if (m < LP) { src[q] = x_prompt + (size_t)m * 1024; gn[q] = args.in[8]; dst[q] = XN + (size_t)m * 1024; }
                else if (m < MT) { src[q] = x_sample + (size_t)(m - LP) * 1024; gn[q] = args.in[8]; dst[q] = XN + (size_t)m * 1024; }
                else { src[q] = args.in[7] + (size_t)(m - MT) * 1024; gn[q] = args.in[15]; dst[q] = MEMN + (size_t)(m - MT) * 1024; }
#pragma unroll
                for (int j = 0; j < 4; ++j) { v[q][j] = ((const f32x4*)src[q])[64 * j + lane]; s[q] += (v[q][j][0] * v[q][j][0] + v[q][j][1] * v[q][j][1]) + (v[q][j][2] * v[q][j][2] + v[q][j][3] * v[q][j][3]); }
            }
#pragma unroll
            for (int q = 0; q < 2; ++q) if (q < nr) {
                const float r = 1.0f / sqrtf(wave_sum(s[q]) * (1.f / 1024.f) + EPS);
#pragma unroll
                for (int j = 0; j < 4; ++j) { const f32x4 gv = ((const f32x4*)gn[q])[64 * j + lane]; *(u32x2*)(dst[q] + 4 * lane + 256 * j) = pack4(v[q][j] * r * gv); }
            }
        }
        for (int idx = gtid; idx < 16392 * 32; idx += NTHR) {
            const int pos = idx >> 5, i = idx & 31;
            double f = 0.15915494309189535;
            for (int k = 0; k < i; ++k) f *= 0.7498942093324559;
            double t = (double)pos * f; t -= floor(t);
            const float ft = (float)t;
            f32x2 cs_; cs_.x = __builtin_amdgcn_cosf(ft); cs_.y = __builtin_amdgcn_sinf(ft); *(f32x2*)(ROPE + 2 * idx) = cs_;
        }
    }
    SEAM(0);
    if (IN_PH(1)) {
        { Gemm g{XN, WIN, MT, NZ, 1024, 1024, 1024, 1 << 20, 1 << 20}; StaticOrder S; S.init(MT, NZ, G, bid); EpiZ E{Z, ROPE, out};
          gemm_phase<EpiZ, StaticOrder, true, true>(lds, g, S, E); }
        { Gemm g{MEMN, WMKV, 256, 1024, 1024, 1024, 1024, 1 << 20, 1 << 20}; RowListOrder S{bid - (G - 4), 4, 0}; EpiMemKV E{MEMK, MEMVT, out};
          gemm_phase<EpiMemKV, RowListOrder, true, true>(lds, g, S, E); }
        {
            int blo = ((MT / 256) * (NZ / 256)) % G, bhi = G - 4; if (bhi - blo < 16) { blo = 0; bhi = G; }
            if (bid >= blo && bid < bhi) {
                LAS float* scr = (LAS float*)(lds + wave * 16384);
                constexpr int I_O = 8 * 32;
                for (int it = (bid - blo) * 8 + wave; it < 3 * I_O; it += (bhi - blo) * 8) { const int n = it / I_O; transpose_item(args.in[17] + (size_t)n * 512 * 1024, 512, 1024, WO, n * 1024, false, scr, it % I_O, lane); }
            }
        }
    }
    SEAM(1);
    if (IN_PH(2)) {
        const float* sinks = args.in[10];
        const bool early = ((bid >> 3) & 1) != 0;
        const int pm_ = args.p2mask;
        if (early && (pm_ & 1)) for (int it = bid; it < 512; it += G) p2_mem_sample(lds, Z, BR, args.in[4], args.in[5], it, tid, wave, lane);
        if (pm_ & 2) for (int it = bid; it < 256; it += G) p2_swa_prompt(lds, Z, BR, sinks, it, tid, wave, lane);
        if (pm_ & 4) for (int it = bid; it < 256; it += G) p2_mem_prompt(lds, Z, BR, MEMK, MEMVT, it, tid, wave, lane);
        if (pm_ & 8) for (int it = bid; it < 256; it += G) p2_sg_prompt(lds, Z, BR, args.in[11], args.in[12], args.in[13], args.in[14], it, tid, wave, lane);
        if (!early && (pm_ & 1)) for (int it = bid; it < 512; it += G) p2_mem_sample(lds, Z, BR, args.in[4], args.in[5], it, tid, wave, lane);
        if (pm_ & 16) for (int it = G - 1 - bid; it < 256; it += G) p2_swa_sample(lds, Z, BR, sinks, args.in[2], args.in[3], out, it, tid, wave, lane);
        if (pm_ & 32) for (int it = bid; it < 128; it += G) p2_sg_sample(lds, Z, BR, args.in[11], args.in[12], args.in[13], args.in[14], out, it, tid, wave, lane);
        __syncthreads();
    }
    SEAM(2);
    if (IN_PH(3)) {
        { Gemm g{BR, WO, LP, 3072, 512, NBR, 512, 4, 1 << 20}; TripleOrder S; S.so.init(LP, 1024, G, bid); EpiGate3 E{Z};
          gemm_phase<EpiGate3, TripleOrder, true, true, true>(lds, g, S, E); }
        { Gemm g{BR, WO, MT, 3072, 512, NBR, 512, 4, 1 << 20}; SampleOrder S{bid}; EpiGate E{Z, args.dry};
          gemm_phase<EpiGate, SampleOrder, true, true>(lds, g, S, E); }
        {
            int blo = 48, bhi = G; if (bhi - blo < 16) blo = 0;
            if (bid >= blo) {
                LAS float* scr = (LAS float*)(lds + wave * 16384);
                constexpr int I_UP = 16 * (NUP / 32), I_DN = (DFF / 64) * 32;
                for (int it = (bid - blo) * 8 + wave; it < I_UP + I_DN; it += (bhi - blo) * 8) {
                    if (it < I_UP) transpose_item(args.in[20], 1024, NUP, WUP, 0, false, scr, it, lane);
                    else transpose_item(args.in[23], DFF, 1024, WDN, 0, false, scr, it - I_UP, lane);
                }
            }
        }
    }
    SEAM(3);
    if (IN_PH(4)) {
        const float* g1 = args.in[18]; const float* g2 = args.in[19];
        for (int rb = gw; rb < LP; rb += 8 * NGW) {
            u32x2 mr[8][4]; f32x4 xv[8][4];
#pragma unroll
            for (int q = 0; q < 8; ++q) {
                const int row = rb + q * NGW < LP ? rb + q * NGW : rb;
                const bf16* zr = Z + (size_t)row * NZ + ZG + 2048 + 4 * lane; const float* xr = x_prompt + (size_t)row * 1024 + 4 * lane;
#pragma unroll
                for (int j = 0; j < 4; ++j) { mr[q][j] = *(const u32x2*)(zr + 256 * j); xv[q][j] = *(const f32x4*)(xr + 256 * j); }
            }
#pragma unroll
            for (int q = 0; q < 8; ++q) if (rb + q * NGW < LP) {
                const int row = rb + q * NGW;
                f32x4 m[4]; float ss = 0.f;
#pragma unroll
                for (int j = 0; j < 4; ++j) { m[j] = (f32x4){bflo(mr[q][j].x), bfhi(mr[q][j].x), bflo(mr[q][j].y), bfhi(mr[q][j].y)}; ss += (m[j][0] * m[j][0] + m[j][1] * m[j][1]) + (m[j][2] * m[j][2] + m[j][3] * m[j][3]); }
                const float r1 = 1.0f / sqrtf(wave_sum(ss) * (1.f / 1024.f) + EPS);
                float s2 = 0.f;
#pragma unroll
                for (int j = 0; j < 4; ++j) {
                    const f32x4 gv = *(const f32x4*)(g1 + 4 * lane + 256 * j);
                    m[j] = xv[q][j] + m[j] * r1 * gv;
                    *(u32x2*)(X1B_ROW(row) + 4 * lane + 256 * j) = pack4(m[j]);
                    s2 += (m[j][0] * m[j][0] + m[j][1] * m[j][1]) + (m[j][2] * m[j][2] + m[j][3] * m[j][3]);
                }
                const float r2 = 1.0f / sqrtf(wave_sum(s2) * (1.f / 1024.f) + EPS);
#pragma unroll
                for (int j = 0; j < 4; ++j) { const f32x4 gv = *(const f32x4*)(g2 + 4 * lane + 256 * j); *(u32x2*)(XN + (size_t)row * 1024 + 4 * lane + 256 * j) = pack4(m[j] * r2 * gv); }
            }
        }
        for (int row = LP + gw; row < MT; row += NGW) {
            const bf16* zr = Z + (size_t)row * NZ + ZG + 4 * lane; const float* xr = x_sample + (size_t)(row - LP) * 1024 + 4 * lane;
            f32x4 m[4], xs[4]; float ss = 0.f;
#pragma unroll
            for (int j = 0; j < 4; ++j) { m[j] = bf4(zr + 2048 + 256 * j) + bf4(zr + 256 * j) + bf4(zr + 1024 + 256 * j); xs[j] = *(const f32x4*)(xr + 256 * j); ss += (m[j][0] * m[j][0] + m[j][1] * m[j][1]) + (m[j][2] * m[j][2] + m[j][3] * m[j][3]); }
            const float r1 = 1.0f / sqrtf(wave_sum(ss) * (1.f / 1024.f) + EPS);
            float s2 = 0.f;
#pragma unroll
            for (int j = 0; j < 4; ++j) {
                const f32x4 gv = *(const f32x4*)(g1 + 4 * lane + 256 * j);
                m[j] = xs[j] + m[j] * r1 * gv;
                *(u32x2*)(X1B_ROW(row) + 4 * lane + 256 * j) = pack4(m[j]);
                s2 += (m[j][0] * m[j][0] + m[j][1] * m[j][1]) + (m[j][2] * m[j][2] + m[j][3] * m[j][3]);
            }
            const float r2 = 1.0f / sqrtf(wave_sum(s2) * (1.f / 1024.f) + EPS);
#pragma unroll
            for (int j = 0; j < 4; ++j) { const f32x4 gv = *(const f32x4*)(g2 + 4 * lane + 256 * j); *(u32x2*)(XN + (size_t)row * 1024 + 4 * lane + 256 * j) = pack4(m[j] * r2 * gv); }
        }
    }
    SEAM(4);
    if (IN_PH(5)) {
        Gemm g{XN, WUP, 69 * 256, NUP, 1024, 1024, 1024, 1 << 20, 1 << 20, 1}; StaticOrder S; S.init(69 * 256, NUP, G, bid);
        EpiConv E{ACT, args.in[21], args.in[22], args.in[6], out, (LAS float*)(lds + 131072)};
        gemm_phase<EpiConv, StaticOrder, true, true>(lds, g, S, E);
    }
    SEAM(5);
    if (IN_PH(7)) {
        { Gemm g{ACT, WDN, LP, 1024, DFF, DFF, DFF, 1 << 20, 1 << 20}; StaticOrder S; S.init(LP, 1024, G, bid); EpiStore<false> E{FB, 1024, nullptr};
          gemm_phase<EpiStore<false>, StaticOrder, true, true>(lds, g, S, E); }
        { Gemm g{ACT, WDN, MT, 1024, 256, DFF, DFF, 4, 4}; SplitOrder S{bid, G}; EpiPart E{PART};
          gemm_phase<EpiPart, SplitOrder, true, true>(lds, g, S, E); }
    }
    SEAM(7);
    if (IN_PH(8)) {
        const float* g3 = args.in[24];
        for (int rb = gw; rb < LP; rb += 8 * NGW) {
            u32x2 fr_[8][4], xr_[8][4];
#pragma unroll
            for (int q = 0; q < 8; ++q) {
                const int row = rb + q * NGW < LP ? rb + q * NGW : rb;
#pragma unroll
                for (int j = 0; j < 4; ++j) { fr_[q][j] = *(const u32x2*)(FB + (size_t)row * 1024 + 4 * lane + 256 * j); xr_[q][j] = *(const u32x2*)(X1B_ROW(row) + 4 * lane + 256 * j); }
            }
#pragma unroll
            for (int q = 0; q < 8; ++q) if (rb + q * NGW < LP) {
                const int row = rb + q * NGW;
                f32x4 f[4]; float ss = 0.f;
#pragma unroll
                for (int j = 0; j < 4; ++j) { f[j] = (f32x4){bflo(fr_[q][j].x), bfhi(fr_[q][j].x), bflo(fr_[q][j].y), bfhi(fr_[q][j].y)}; ss += (f[j][0] * f[j][0] + f[j][1] * f[j][1]) + (f[j][2] * f[j][2] + f[j][3] * f[j][3]); }
                const float r = 1.0f / sqrtf(wave_sum(ss) * (1.f / 1024.f) + EPS);
#pragma unroll
                for (int j = 0; j < 4; ++j) {
                    const f32x4 gv = *(const f32x4*)(g3 + 4 * lane + 256 * j);
                    const f32x4 xo = (f32x4){bflo(xr_[q][j].x), bfhi(xr_[q][j].x), bflo(xr_[q][j].y), bfhi(xr_[q][j].y)};
                    const f32x4 yv = xo + f[j] * r * gv;
                    if (!args.dry) *(f32x4*)(out + (size_t)row * 1024 + 4 * lane + 256 * j) = yv;
                }
            }
        }
        for (int row = LP + gw; row < MT; row += NGW) {
            f32x4 f[4], xo[4]; float ss = 0.f;
#pragma unroll
            for (int j = 0; j < 4; ++j) {
                f[j] = (f32x4){0.f, 0.f, 0.f, 0.f};
#pragma unroll
                for (int ks = 0; ks < 11; ++ks) f[j] = f[j] + bf4(PART + ((size_t)ks * 1024 + (row - LP)) * 1024 + 4 * lane + 256 * j);
                xo[j] = bf4(X1B_ROW(row) + 4 * lane + 256 * j);
                ss += (f[j][0] * f[j][0] + f[j][1] * f[j][1]) + (f[j][2] * f[j][2] + f[j][3] * f[j][3]);
            }
            const float r = 1.0f / sqrtf(wave_sum(ss) * (1.f / 1024.f) + EPS);
#pragma unroll
            for (int j = 0; j < 4; ++j) {
                const f32x4 gv = *(const f32x4*)(g3 + 4 * lane + 256 * j);
                const f32x4 yv = xo[j] + f[j] * r * gv;
                if (!args.dry) *(f32x4*)(out + (size_t)row * 1024 + 4 * lane + 256 * j) = yv;
            }
        }
    }
#undef IN_PH
#undef SEAM
}
}

#ifndef MK_N_LAUNCHES
#define MK_N_LAUNCHES 1
#endif
extern "C" void kernel_launch(void* const* d_in, const int* in_sizes, int n_in, void* d_out, int out_size, void* d_ws, size_t ws_size, hipStream_t stream) {
    static int grid = 0;
    if (grid == 0) {
        if (n_in != 25 || out_size != (int)pg8::O_END || ws_size < pg8::W_END) { fprintf(stderr, "kernel_launch: unexpected shapes: n_in %d out %d ws %zu (need %zu)\n", n_in, out_size, ws_size, (size_t)pg8::W_END); grid = -1; return; }
        int dev = 0, cus = 0, per_cu = 0;
        if (hipGetDevice(&dev) != hipSuccess || hipDeviceGetAttribute(&cus, hipDeviceAttributeMultiprocessorCount, dev) != hipSuccess) { grid = -1; return; }
        if (hipFuncSetAttribute((const void*)pg8::fwd_mega, hipFuncAttributeMaxDynamicSharedMemorySize, pg8::LDS_BYTES) != hipSuccess) { fprintf(stderr, "kernel_launch: hipFuncSetAttribute failed\n"); grid = -1; return; }
        if (hipOccupancyMaxActiveBlocksPerMultiprocessor(&per_cu, (const void*)pg8::fwd_mega, 512, pg8::LDS_BYTES) != hipSuccess || per_cu < 1) { fprintf(stderr, "kernel_launch: occupancy query says %d blocks per CU\n", per_cu); per_cu = 1; }
        (void)hipGetLastError();
        grid = cus;
    }
    if (grid < 0) return;
    pg8::Args a{};
    for (int i = 0; i < 25; ++i) a.in[i] = (const float*)d_in[i];
    a.out = (float*)d_out; a.ws = (unsigned char*)d_ws; a.p2mask = 63; a.nbar = 1;
#if MK_N_LAUNCHES == 1
    a.ph_lo = 0; a.ph_hi = 9;
#ifdef MK_PROBE_NBAR
    a.nbar = MK_PROBE_NBAR;
#endif
    if (hipMemsetAsync((char*)d_ws + pg8::W_CTL, 0, pg8::CTL_BYTES, stream) != hipSuccess) { fprintf(stderr, "kernel_launch: memset failed\n"); return; }
    hipLaunchKernelGGL(pg8::fwd_mega, dim3(grid), dim3(512), pg8::LDS_BYTES, stream, a);
#else
    const int cuts[4] = {0, MK_PROBE_PHASE + 1, MK_PROBE_PHASE, MK_PROBE_PHASE + 1};
    for (int li = 0; li < 3; ++li) {
        a.ph_lo = li == 0 ? 0 : (li == 1 ? MK_PROBE_PHASE : MK_PROBE_PHASE + 1); a.ph_hi = li == 2 ? 9 : MK_PROBE_PHASE + 1; (void)cuts;
#ifdef MK_PROBE_DRY
        a.ph_lo = li == 0 ? 0 : MK_PROBE_PHASE; a.ph_hi = li == 0 ? MK_PROBE_PHASE : (li == 1 ? MK_PROBE_PHASE + 1 : 9); a.dry = li == 1 ? 1 : 0;
#endif
        if (a.ph_lo >= a.ph_hi) continue;
#ifdef MK_PROBE_P2MASK
        a.p2mask = li == 1 ? MK_PROBE_P2MASK : 63;
#endif
        (void)hipMemsetAsync((char*)d_ws + pg8::W_CTL, 0, pg8::CTL_BYTES, stream);
        hipLaunchKernelGGL(pg8::fwd_mega, dim3(grid), dim3(512), pg8::LDS_BYTES, stream, a);
    }
#endif
}
```
